# Optimizing an MI355X kernel written in HIP

```python
import math
import jax
import jax.numpy as jnp
from jax import lax
import numpy as np

D_MODEL = 1024
BATCH = 1
SEQ = 16384
DEPTH = 2
DEC_BATCH = 32
DEC_SEQ = 1
PAST_LEN = 16384
PAGE_SIZE = 128

EPS = 1e-6
PLE_DIM = 256
D_FF = ((8 * D_MODEL // 3 + 127) // 128) * 128
CONV_DIM = D_MODEL // 2
CONV_W = 3
RET_HEADS = 4
RET_DK = 128
RET_DV = 128
RET_DIM = RET_HEADS * RET_DK
RET_VDIM = RET_HEADS * RET_DV
RET_CHUNK = 128
RET_THETA = 10000.0
ATTN_GROUPS = ((128, 1), (512, 4), (2048, 16))
ATTN_HEADS = 4
HEAD_DIM = 64
ATTN_DIM = ATTN_HEADS * HEAD_DIM
ATTN_SCALE = HEAD_DIM ** -0.5
ROT_DIM = HEAD_DIM // 4
ROPE_THETA = 500000.0
ATTN_BLOCK = 128
NEG = -1e30
IN_SIZES = [CONV_DIM] * 3 + [RET_DIM, RET_DIM, RET_VDIM, RET_VDIM] + [ATTN_DIM] * (3 * len(ATTN_GROUPS))
N_IN = sum(IN_SIZES)
N_BRANCH = 3

kernel_name = 'hybrid_conv_retention_dilated_attn_decoder_step'


def rms_norm(x, g):
    xf = x.astype(jnp.float32)
    y = xf * lax.rsqrt(jnp.mean(xf * xf, axis=-1, keepdims=True) + EPS)
    return (y * g.astype(jnp.float32)).astype(x.dtype)


def swiglu(x, w_gu, w_down):
    gate, up = jnp.split(x @ w_gu, 2, axis=-1)
    return (jax.nn.silu(gate) * up) @ w_down


def rotary(x, pos, rot_dim, theta):
    half = rot_dim // 2
    inv_freq = jnp.exp(-jnp.arange(half, dtype=jnp.float32) * (math.log(theta) / half))
    ang = pos.astype(jnp.float32)[:, None] * inv_freq[None, :]
    cos = jnp.cos(ang)[:, None, :]
    sin = jnp.sin(ang)[:, None, :]
    xr = x[..., :rot_dim].astype(jnp.float32)
    x1, x2 = xr[..., :half], xr[..., half:]
    rot = jnp.concatenate([x1 * cos - x2 * sin, x2 * cos + x1 * sin], axis=-1).astype(x.dtype)
    if rot_dim == x.shape[-1]:
        return rot
    return jnp.concatenate([rot, x[..., rot_dim:]], axis=-1)


def short_conv(b_gate, c_gate, h, hist, w_conv, b_conv):
    u = c_gate * h
    t = u.shape[1]
    ext = jnp.concatenate([hist.astype(u.dtype), u], axis=1)
    y = b_conv + w_conv[0] * ext[:, 0:t]
    for j in range(1, CONV_W):
        y = y + w_conv[j] * ext[:, j:j + t]
    return b_gate * y, ext[:, -(CONV_W - 1):]


def retention(q, k, v, s0, chunk):
    f32 = jnp.float32
    b, t, nh, dk = q.shape
    dv = v.shape[-1]
    n = t // chunk
    log_g = jnp.log1p(-jnp.exp2(-5.0 - jnp.arange(nh, dtype=f32)))
    qc = q.astype(f32).reshape(b, n, chunk, nh, dk)
    kc = k.astype(f32).reshape(b, n, chunk, nh, dk)
    vc = v.astype(f32).reshape(b, n, chunk, nh, dv)
    i = jnp.arange(chunk, dtype=f32)
    diff = i[:, None] - i[None, :]
    decay = jnp.where(diff[None] >= 0, jnp.exp(jnp.maximum(diff, 0.0)[None] * log_g[:, None, None]), 0.0)
    scores = jnp.einsum('bnihd,bnjhd->bnhij', qc, kc) * decay
    o_intra = jnp.einsum('bnhij,bnjhe->bnihe', scores, vc)
    k_w = jnp.exp((chunk - 1 - i)[:, None] * log_g[None, :])
    kv = jnp.einsum('bnjhd,jh,bnjhe->nbhde', kc, k_w, vc)
    g_chunk = jnp.exp(chunk * log_g)[:, None, None]

    def step(s, kv_c):
        return s * g_chunk + kv_c, s

    s_final, s_before = lax.scan(step, s0.astype(f32), kv)
    q_w = jnp.exp((i + 1)[:, None] * log_g[None, :])
    o_inter = jnp.einsum('bnihd,ih,nbhde->bnihe', qc, q_w, s_before)
    return (o_intra + o_inter).reshape(b, t, nh, dv), s_final


def head_norm(o):
    mu = jnp.mean(o, axis=-1, keepdims=True)
    var = jnp.mean(jnp.square(o - mu), axis=-1, keepdims=True)
    return (o - mu) * lax.rsqrt(var + EPS)


def dilated_attn_prompt(q, k, v, dil, n_back):
    f32 = jnp.float32
    b, s, nh, dh = q.shape
    L = -(-s // dil)
    qb = ATTN_BLOCK if L > ATTN_BLOCK else L
    nb = -(-L // qb)

    def to_blocks(x):
        x = jnp.pad(x, ((0, 0), (0, L * dil - s), (0, 0), (0, 0)))
        x = jnp.moveaxis(x.reshape(b, L, dil, nh, dh), 2, 1).reshape(b * dil, L, nh, dh)
        x = jnp.pad(x, ((0, 0), (0, nb * qb - L), (0, 0), (0, 0)))
        return x.reshape(b * dil, nb, qb, nh, dh).astype(f32)

    def with_prev(x):
        prev = jnp.pad(x, ((0, 0), (1, 0), (0, 0), (0, 0), (0, 0)))[:, :-1]
        return jnp.concatenate([prev, x], axis=2)

    def from_blocks(x):
        tail = x.shape[3:]
        x = x.reshape((b * dil, nb * qb) + tail)[:, :L]
        x = jnp.moveaxis(x.reshape((b, dil, L) + tail), 1, 2).reshape((b, L * dil) + tail)
        return x[:, :s]

    qs = to_blocks(q)
    kk = with_prev(to_blocks(k))
    vv = with_prev(to_blocks(v))
    qi = jnp.arange(nb)[:, None] * qb + jnp.arange(qb)[None, :]
    kj = qi[:, :1] - qb + jnp.arange(2 * qb)[None, :]
    dist = qi[:, :, None] - kj[:, None, :]
    valid = (dist >= 0) & (dist <= n_back) & (kj[:, None, :] >= 0)
    sc = jnp.einsum('nbihd,nbjhd->nbhij', qs, kk) * ATTN_SCALE
    sc = jnp.where(valid[None, :, None], sc, NEG)
    lse = jax.nn.logsumexp(sc, axis=-1)
    o = jnp.einsum('nbhij,nbjhd->nbihd', jnp.exp(sc - lse[..., None]), vv)
    return from_blocks(o), from_blocks(jnp.swapaxes(lse, 2, 3))


def dilated_attn_decode(q, k, v, hist, dil, n_back):
    f32 = jnp.float32
    w = hist.shape[1]
    t = q.shape[1]
    k_all = jnp.concatenate([hist[:, :, 0].astype(k.dtype), k], axis=1)
    v_all = jnp.concatenate([hist[:, :, 1].astype(v.dtype), v], axis=1)
    idx = (w + jnp.arange(t))[:, None] - dil * jnp.arange(n_back + 1)[None, :]
    valid = idx >= 0
    idx = jnp.maximum(idx, 0)
    kg = jnp.take(k_all, idx, axis=1).astype(f32)
    vg = jnp.take(v_all, idx, axis=1).astype(f32)
    sc = jnp.einsum('bthd,btnhd->bthn', q.astype(f32), kg) * ATTN_SCALE
    sc = jnp.where(valid[None, :, None, :], sc, NEG)
    lse = jax.nn.logsumexp(sc, axis=-1)
    o = jnp.einsum('bthn,btnhd->bthd', jnp.exp(sc - lse[..., None]), vg)
    new_hist = jnp.stack([k_all[:, -w:], v_all[:, -w:]], axis=2)
    return o, lse, new_hist


def decoder_layer(x, ple, pos, conv_hist, ret_state, kv_hist, lw):
    g = lw['norm']
    bsz, t, _ = x.shape
    x = x + 0.5 * rms_norm(swiglu(rms_norm(x, g[0]), lw['ffn1_gu'], lw['ffn1_down']), g[1])

    h = rms_norm(x, g[2])
    offs = np.cumsum(IN_SIZES)[:-1].tolist()
    parts = jnp.split(h @ lw['w_in'], offs, axis=-1)

    def heads(a, d):
        return a.reshape(bsz, t, -1, d)

    conv_y, conv_state = short_conv(parts[0], parts[1], parts[2], conv_hist, lw['w_conv'], lw['b_conv'])

    rq = rotary(heads(parts[3], RET_DK), pos, RET_DK, RET_THETA)
    rk = rotary(heads(parts[4], RET_DK), pos, RET_DK, RET_THETA) * (RET_DK ** -0.5)
    chunk = RET_CHUNK if t % RET_CHUNK == 0 else t
    ro, ret_state = retention(rq, rk, heads(parts[5], RET_DV), ret_state, chunk)
    ret_y = head_norm(ro).reshape(bsz, t, RET_VDIM).astype(x.dtype) * jax.nn.silu(parts[6])

    outs, lses, new_kv = [], [], []
    for gi, (window, dil) in enumerate(ATTN_GROUPS):
        base = 7 + 3 * gi
        aq = rotary(heads(parts[base], HEAD_DIM), pos, ROT_DIM, ROPE_THETA)
        ak = rotary(heads(parts[base + 1], HEAD_DIM), pos, ROT_DIM, ROPE_THETA)
        av = heads(parts[base + 2], HEAD_DIM)
        if kv_hist is None:
            o, lse = dilated_attn_prompt(aq, ak, av, dil, window // dil)
            keep = min(window, t)
            kv = jnp.stack([ak[:, -keep:], av[:, -keep:]], axis=2)
        else:
            o, lse, kv = dilated_attn_decode(aq, ak, av, kv_hist[gi], dil, window // dil)
        outs.append(o)
        lses.append(lse)
        new_kv.append(kv)
    wts = jax.nn.softmax(jnp.stack(lses), axis=0)
    attn_o = jnp.sum(wts[..., None] * jnp.stack(outs), axis=0)
    attn_y = attn_o.reshape(bsz, t, ATTN_DIM).astype(x.dtype)

    gates = jax.nn.sigmoid((h @ lw['w_gate']).astype(jnp.float32)).astype(x.dtype)
    g_conv, g_ret, g_attn = jnp.split(gates, N_BRANCH, axis=-1)
    merged = (g_conv * (conv_y @ lw['w_conv_out']) + g_ret * (ret_y @ lw['w_ret_out'])
              + g_attn * (attn_y @ lw['w_attn_out']))
    x = x + rms_norm(merged @ lw['w_o'], g[3])

    x = x + 0.5 * rms_norm(swiglu(rms_norm(x, g[4]), lw['ffn2_gu'], lw['ffn2_down']), g[5])

    gate = jax.nn.sigmoid((rms_norm(x, g[6]) @ lw['w_ple_gate']).astype(jnp.float32)).astype(x.dtype)
    x = x + rms_norm(gate * (ple @ lw['w_ple_proj']), g[7])
    return x, conv_state, ret_state, new_kv


def setup_inputs(seed: int = 0) -> dict:
    key = jax.random.key(seed)
    keys = iter(jax.random.split(key, 32))

    def nrm(shape, scale):
        return jax.random.normal(next(keys), shape, jnp.float32) * scale

    bufs = [min(w, PAST_LEN) for w, _ in ATTN_GROUPS]
    return {
        'x_prompt': nrm((BATCH, SEQ, D_MODEL), 1.0),
        'x_sample': nrm((DEC_BATCH, DEC_SEQ, D_MODEL), 1.0),
        'state_conv': nrm((DEPTH, DEC_BATCH, CONV_W - 1, CONV_DIM), 1.0),
        'state_ret': nrm((DEPTH, DEC_BATCH, RET_HEADS, RET_DK, RET_DV), 1.0),
        'cache_kv_w128': nrm((DEPTH, DEC_BATCH, bufs[0], 2, ATTN_HEADS, HEAD_DIM), 1.0),
        'cache_kv_w512': nrm((DEPTH, DEC_BATCH, bufs[1], 2, ATTN_HEADS, HEAD_DIM), 1.0),
        'cache_kv_w2048': nrm((DEPTH, DEC_BATCH, bufs[2], 2, ATTN_HEADS, HEAD_DIM), 1.0),
        'p_prompt': nrm((DEPTH, BATCH, SEQ, PLE_DIM), 1.0),
        'p_sample': nrm((DEPTH, DEC_BATCH, DEC_SEQ, PLE_DIM), 1.0),
        'norm_gain': 1.0 + nrm((DEPTH, 8, D_MODEL), 0.02),
        'w_ffn1_gu': nrm((DEPTH, D_MODEL, 2 * D_FF), D_MODEL ** -0.5),
        'w_ffn1_down': nrm((DEPTH, D_FF, D_MODEL), D_FF ** -0.5),
        'w_in': nrm((DEPTH, D_MODEL, N_IN), D_MODEL ** -0.5),
        'w_conv': nrm((DEPTH, CONV_W, CONV_DIM), CONV_W ** -0.5),
        'b_conv': nrm((DEPTH, CONV_DIM), 0.02),
        'w_conv_out': nrm((DEPTH, CONV_DIM, D_MODEL), CONV_DIM ** -0.5),
        'w_ret_out': nrm((DEPTH, RET_VDIM, D_MODEL), RET_VDIM ** -0.5),
        'w_attn_out': nrm((DEPTH, ATTN_DIM, D_MODEL), ATTN_DIM ** -0.5),
        'w_gate': nrm((DEPTH, D_MODEL, N_BRANCH * D_MODEL), D_MODEL ** -0.5),
        'w_o': nrm((DEPTH, D_MODEL, D_MODEL), D_MODEL ** -0.5),
        'w_ffn2_gu': nrm((DEPTH, D_MODEL, 2 * D_FF), D_MODEL ** -0.5),
        'w_ffn2_down': nrm((DEPTH, D_FF, D_MODEL), D_FF ** -0.5),
        'w_ple_gate': nrm((DEPTH, D_MODEL, D_MODEL), D_MODEL ** -0.5),
        'w_ple_proj': nrm((DEPTH, PLE_DIM, D_MODEL), PLE_DIM ** -0.5),
    }


def reference(x_prompt, x_sample, state_conv, state_ret, cache_kv_w128, cache_kv_w512, cache_kv_w2048,
              p_prompt, p_sample, norm_gain, w_ffn1_gu, w_ffn1_down, w_in, w_conv, b_conv,
              w_conv_out, w_ret_out, w_attn_out, w_gate, w_o, w_ffn2_gu, w_ffn2_down,
              w_ple_gate, w_ple_proj):
    pos_p = jnp.arange(x_prompt.shape[1])
    pos_s = PAST_LEN + jnp.arange(x_sample.shape[1])
    conv0 = jnp.zeros((x_prompt.shape[0], CONV_W - 1, CONV_DIM), x_prompt.dtype)
    ret0 = jnp.zeros((x_prompt.shape[0], RET_HEADS, RET_DK, RET_DV), jnp.float32)
    yp, ys = x_prompt, x_sample
    conv_p, conv_s, ret_p, ret_s = [], [], [], []
    kv_p = [[] for _ in ATTN_GROUPS]
    kv_s = [[] for _ in ATTN_GROUPS]
    for l in range(DEPTH):
        lw = {
            'norm': norm_gain[l], 'ffn1_gu': w_ffn1_gu[l], 'ffn1_down': w_ffn1_down[l],
            'w_in': w_in[l], 'w_conv': w_conv[l], 'b_conv': b_conv[l],
            'w_conv_out': w_conv_out[l], 'w_ret_out': w_ret_out[l], 'w_attn_out': w_attn_out[l],
            'w_gate': w_gate[l], 'w_o': w_o[l], 'ffn2_gu': w_ffn2_gu[l], 'ffn2_down': w_ffn2_down[l],
            'w_ple_gate': w_ple_gate[l], 'w_ple_proj': w_ple_proj[l],
        }
        yp, cp, rp, kp = decoder_layer(yp, p_prompt[l], pos_p, conv0, ret0, None, lw)
        ys, cs, rs, ks = decoder_layer(ys, p_sample[l], pos_s, state_conv[l], state_ret[l],
                                       (cache_kv_w128[l], cache_kv_w512[l], cache_kv_w2048[l]), lw)
        conv_p.append(cp)
        conv_s.append(cs)
        ret_p.append(rp)
        ret_s.append(rs)
        for gi in range(len(ATTN_GROUPS)):
            kv_p[gi].append(kp[gi])
            kv_s[gi].append(ks[gi])
    return (yp, ys, jnp.stack(conv_p), jnp.stack(conv_s), jnp.stack(ret_p), jnp.stack(ret_s),
            jnp.stack(kv_p[0]), jnp.stack(kv_s[0]), jnp.stack(kv_p[1]), jnp.stack(kv_s[1]),
            jnp.stack(kv_p[2]), jnp.stack(kv_s[2]))
```

```cpp
#include <hip/hip_runtime.h>
#include <cstdio>
#include <cstdint>

constexpr int DM = 1024, SEQ = 16384, NBATCH = 32, MV = SEQ + NBATCH  , MT = 16640  ;
constexpr int DFF = 2816, NGU = 2 * DFF, NIN = 5888, NGATE = 3072, NINT = NIN + NGATE  , PLE = 256, DEPTH = 2;
constexpr int CONVD = 512, RETD = 512, ATTD = 256, NGRP = 3;
constexpr float EPS = 1e-6f;
constexpr float LOG2E = 1.4426950408889634f, LN2 = 0.6931471805599453f;

constexpr size_t OUT_YP = 0;
constexpr size_t OUT_YS = OUT_YP + (size_t)SEQ * DM;
constexpr size_t OUT_CONVP = OUT_YS + (size_t)NBATCH * DM;
constexpr size_t OUT_CONVS = OUT_CONVP + (size_t)DEPTH * 2 * CONVD;
constexpr size_t OUT_RETP = OUT_CONVS + (size_t)DEPTH * NBATCH * 2 * CONVD;
constexpr size_t OUT_RETS = OUT_RETP + (size_t)DEPTH * 4 * 128 * 128;
constexpr size_t OUT_KV128P = OUT_RETS + (size_t)DEPTH * NBATCH * 4 * 128 * 128;
constexpr size_t OUT_KV128S = OUT_KV128P + (size_t)DEPTH * 128 * 512;
constexpr size_t OUT_KV512P = OUT_KV128S + (size_t)DEPTH * NBATCH * 128 * 512;
constexpr size_t OUT_KV512S = OUT_KV512P + (size_t)DEPTH * 512 * 512;
constexpr size_t OUT_KV2048P = OUT_KV512S + (size_t)DEPTH * NBATCH * 512 * 512;
constexpr size_t OUT_KV2048S = OUT_KV2048P + (size_t)DEPTH * 2048 * 512;
constexpr size_t OUT_END = OUT_KV2048S + (size_t)DEPTH * NBATCH * 2048 * 512;

constexpr size_t al256(size_t x) { return (x + 255) & ~(size_t)255; }
constexpr size_t WS_CTL = 0, CTL_ZERO_BYTES = 65536;
constexpr size_t WL_GU1 = 0;
constexpr size_t WL_D1 = WL_GU1 + (size_t)NGU * DM * 2;
constexpr size_t WL_IN = WL_D1 + (size_t)DM * DFF * 2;
constexpr size_t WL_CO = WL_IN + (size_t)NINT * DM * 2;
constexpr size_t WL_RO = WL_CO + (size_t)DM * CONVD * 2;
constexpr size_t WL_AO = WL_RO + (size_t)DM * RETD * 2;
constexpr size_t WL_WO = WL_AO + (size_t)DM * ATTD * 2;
constexpr size_t WL_GU2 = WL_WO + (size_t)DM * DM * 2;
constexpr size_t WL_D2 = WL_GU2 + (size_t)NGU * DM * 2;
constexpr size_t WL_PG = WL_D2 + (size_t)DM * DFF * 2;
constexpr size_t WL_PP = WL_PG + (size_t)DM * DM * 2;
constexpr size_t WL_SIZE = WL_PP + (size_t)DM * PLE * 2;
constexpr size_t WS_W = 1u << 20;
constexpr size_t WS_X = al256(WS_W + DEPTH * WL_SIZE);
constexpr size_t WS_H = WS_X + (size_t)MT * DM * 4;
constexpr size_t WS_ACT = WS_H + (size_t)MT * DM * 2;
constexpr size_t WS_F = WS_ACT + (size_t)MT * DFF * 2;
constexpr size_t WS_ZB = WS_F + (size_t)MT * DM * 4;
constexpr size_t WS_ZU = WS_ZB + (size_t)MT * 512 * 2;
constexpr size_t WS_RQ = WS_ZU + (size_t)MT * 512 * 2;
constexpr size_t WS_RK = WS_RQ + (size_t)MT * 512 * 2;
constexpr size_t WS_RV = WS_RK + (size_t)MT * 512 * 2;
constexpr size_t WS_RG = WS_RV + (size_t)MT * 512 * 2;
constexpr size_t WS_AQ = WS_RG + (size_t)MT * 512 * 2;
constexpr size_t WS_AK = WS_AQ + (size_t)3 * MT * 256 * 2;
constexpr size_t WS_AV = WS_AK + (size_t)3 * MT * 256 * 2;
constexpr size_t WS_GATES = WS_AV + (size_t)3 * MT * 256 * 2;
constexpr size_t WS_CONVY = WS_GATES + (size_t)MT * NGATE * 2;
constexpr size_t WS_RETY = WS_CONVY + (size_t)MT * 512 * 2;
constexpr size_t WS_ATTY = WS_RETY + (size_t)MT * 512 * 2;
constexpr size_t WS_AO = WS_ATTY + (size_t)MT * 256 * 2;
constexpr size_t WS_LSE = WS_AO + (size_t)3 * MT * 256 * 2;
constexpr size_t WS_MERGED = WS_LSE + (size_t)3 * MT * 4 * 4;
constexpr size_t WS_PP = WS_MERGED + (size_t)MT * DM * 2;
constexpr size_t WS_PLEB = WS_PP + (size_t)MT * DM * 4;
constexpr size_t WS_KVC = WS_PLEB + (size_t)2 * MT * PLE * 2;
constexpr size_t WS_SB = WS_KVC + (size_t)128 * 4 * 128 * 128 * 4;
constexpr size_t WS_TABF = WS_SB + (size_t)128 * 4 * 128 * 128 * 2;
constexpr size_t WS_TABP = al256(WS_TABF + (size_t)(SEQ + 1) * 64 * 8);
constexpr size_t WS_END = al256(WS_TABP + (size_t)(SEQ + 1) * 8 * 8);

#define GAS __attribute__((address_space(1)))
#define LAS __attribute__((address_space(3)))
typedef unsigned short bf16;
typedef unsigned v4u __attribute__((ext_vector_type(4)));
typedef unsigned v2u __attribute__((ext_vector_type(2)));
typedef float f32x4 __attribute__((ext_vector_type(4)));
typedef float f32x2 __attribute__((ext_vector_type(2)));
typedef short bf16x8 __attribute__((ext_vector_type(8)));
typedef short s16x4 __attribute__((ext_vector_type(4)));

__device__ __forceinline__ float bf2f(unsigned short b) { return __builtin_bit_cast(float, (unsigned)b << 16); }
__device__ __forceinline__ float bflo(unsigned w) { return __builtin_bit_cast(float, w << 16); }
__device__ __forceinline__ float bfhi(unsigned w) { return __builtin_bit_cast(float, w & 0xffff0000u); }
__device__ __forceinline__ unsigned f2bf(float f) { unsigned u = __builtin_bit_cast(unsigned, f); return (u + 0x7fffu + ((u >> 16) & 1u)) >> 16; }
__device__ __forceinline__ unsigned pk2(float lo, float hi) { return f2bf(lo) | (f2bf(hi) << 16); }
__device__ __forceinline__ float silu_f(float x) { return x * __builtin_amdgcn_rcpf(1.f + __builtin_amdgcn_exp2f(-LOG2E * x)); }
__device__ __forceinline__ float sigm_f(float x) { return __builtin_amdgcn_rcpf(1.f + __builtin_amdgcn_exp2f(-LOG2E * x)); }
namespace pg8 {
#define PG8_LAS __attribute__((address_space(3)))
typedef unsigned short bf16_t;
typedef short bf16x8 __attribute__((ext_vector_type(8)));
typedef float f32x4 __attribute__((ext_vector_type(4)));
typedef unsigned u32x4 __attribute__((ext_vector_type(4)));
constexpr int BM = 256, BK = 64, HALF = 128, HTB = HALF * BK * 2  , STAGE_BYTES = 8 * HTB, NXCD = 8, WGM = 8;

__host__ __device__ __forceinline__ int lds_byte(int r, int c) { const int st = (r >> 4) * 2 + (c >> 5), rr = r & 15, cc = c & 31, ob = rr * 64 + cc * 2; return st * 1024 + (ob ^ (((ob >> 9) & 1) << 5)); }
__host__ __device__ __forceinline__ void stage_rc(int b, int& R, int& C) { const int st = b / 1024, sb = b % 1024, swz = sb ^ (((sb >> 9) & 1) << 5); R = (st >> 1) * 16 + swz / 64; C = (st & 1) * 32 + (swz % 64) / 2; }
__host__ __device__ __forceinline__ int perm32(int rho) { const int n = rho >> 4, i = rho & 15; return 8 * (i >> 2) + 4 * n + (i & 3); }

struct Unit { int pm, pn; };
struct Gemm { const bf16_t* A; const bf16_t* Bt; int M, N, K; };

struct StaticOrder {
    int nM, nN, nwg, G, c;
    __host__ __device__ void init(int M, int N, int G_, int c_) { nM = M / BM; nN = N / BM; nwg = nM * nN; G = G_; c = c_; }
    __host__ __device__ bool next(int i, Unit& u) const {
        const long L = (long)i * G + c; if (L >= nwg) return false;
        int wgid = (int)L; { const int q = nwg / NXCD, r = nwg % NXCD, xcd = wgid % NXCD, off = wgid / NXCD; wgid = (xcd < r ? xcd * (q + 1) : r * (q + 1) + (xcd - r) * q) + off; }
        const int nig = WGM * nN, gid = wgid / nig, fm = gid * WGM, gsz = (nM - fm) < WGM ? (nM - fm) : WGM;
        u.pm = fm + ((wgid % nig) % gsz); u.pn = (wgid % nig) / gsz; return true;
    }
    __device__ __forceinline__ void a_ready(const Unit&) const {}
    __device__ __forceinline__ void done(const Unit&) const {}
};

__device__ __forceinline__ unsigned cvt_pk_bf16(float lo, float hi) { unsigned r; asm volatile("v_cvt_pk_bf16_f32 %0, %1, %2" : "=v"(r) : "v"(lo), "v"(hi)); return r; }
typedef float f32x2 __attribute__((ext_vector_type(2)));
__device__ __forceinline__ u32x4 pack8(const f32x4 v0, const f32x4 v1) { u32x4 w; w.x = cvt_pk_bf16(v0[0], v0[1]); w.y = cvt_pk_bf16(v0[2], v0[3]); w.z = cvt_pk_bf16(v1[0], v1[1]); w.w = cvt_pk_bf16(v1[2], v1[3]); return w; }
__device__ __forceinline__ void unpack8(const u32x4 w, f32x4& a, f32x4& b) { a = (f32x4){bflo(w.x), bfhi(w.x), bflo(w.y), bfhi(w.y)}; b = (f32x4){bflo(w.z), bfhi(w.z), bflo(w.w), bfhi(w.w)}; }

struct EpiSwiGLU {
    static constexpr bool PERM = true, AFTER_DRAIN = false;
    bf16_t* O; int ldc;
    __device__ __forceinline__ void operator()(const f32x4 (&acc)[2][2][4][2], const Unit& u, int wr, int wc, int fr, int fq) const {
        asm volatile("" : "+v"(fr), "+v"(fq));
        const int row0 = u.pm * BM + wr * 64 + fr, col0 = u.pn * HALF + wc * 32 + 8 * fq;
#pragma unroll
        for (int ai = 0; ai < 2; ++ai)
#pragma unroll
            for (int m = 0; m < 4; ++m) { bf16_t* rowp = O + (size_t)(row0 + ai * HALF + m * 16) * ldc + col0;
                f32x4 v0, v1;
#pragma unroll
                for (int k = 0; k < 4; ++k) { v0[k] = silu_f(acc[ai][0][m][0][k]) * acc[ai][1][m][0][k]; v1[k] = silu_f(acc[ai][0][m][1][k]) * acc[ai][1][m][1][k]; }
                *(u32x4*)rowp = pack8(v0, v1); }
    }
};

struct EpiGen {
    static constexpr bool PERM = true, AFTER_DRAIN = false;
    int mode; float* F; const bf16_t* gate; bf16_t* MB; const float* PP;
    __device__ __forceinline__ void operator()(const f32x4 (&acc)[2][2][4][2], const Unit& u, int wr, int wc, int fr, int fq) const {
        asm volatile("" : "+v"(fr), "+v"(fq));
        const int row0 = u.pm * BM + wr * 64 + fr, col0 = u.pn * BM + wc * 32 + 8 * fq;
#pragma unroll
        for (int ai = 0; ai < 2; ++ai)
#pragma unroll
            for (int m = 0; m < 4; ++m) { const size_t row = (size_t)(row0 + ai * HALF + m * 16);
#pragma unroll
                for (int bj = 0; bj < 2; ++bj) { const int col = col0 + bj * HALF; f32x4 v0 = acc[ai][bj][m][0], v1 = acc[ai][bj][m][1];
                    float* fp = F + row * DM + col;
                    if (mode == 0) { *(f32x4*)fp = v0; *(f32x4*)(fp + 4) = v1; }
                    else if (mode == 4) { const f32x4 p0 = *(const f32x4*)(PP + row * DM + col), p1 = *(const f32x4*)(PP + row * DM + col + 4);
#pragma unroll
                        for (int k = 0; k < 4; ++k) { v0[k] = sigm_f(v0[k]) * p0[k]; v1[k] = sigm_f(v1[k]) * p1[k]; }
                        *(f32x4*)fp = v0; *(f32x4*)(fp + 4) = v1; }
                    else { const u32x4 gw = *(const u32x4*)(gate + row * NGATE + col); f32x4 g0, g1; unpack8(gw, g0, g1); v0 = v0 * g0; v1 = v1 * g1;
                        if (mode >= 2) { v0 = v0 + __builtin_nontemporal_load((const f32x4*)fp); v1 = v1 + __builtin_nontemporal_load((const f32x4*)(fp + 4)); }
                        if (mode == 3) *(u32x4*)(MB + row * DM + col) = pack8(v0, v1); else { *(f32x4*)fp = v0; *(f32x4*)(fp + 4) = v1; } }
                } }
    }
};

struct EpiIn {
    static constexpr bool PERM = true, AFTER_DRAIN = false;
    bf16_t *ZB, *ZU, *RQ, *RK, *RV, *RG, *AQ, *AK, *AV, *GATES; const f32x2* TABF; const f32x2* TABP;
    template <int ACT> __device__ __forceinline__ void plain(const f32x4 (&acc)[2][2][4][2], bf16_t* dst, int ld, int row0, int cl) const {
#pragma unroll
        for (int ai = 0; ai < 2; ++ai)
#pragma unroll
            for (int m = 0; m < 4; ++m) { bf16_t* rowp = dst + (size_t)(row0 + ai * HALF + m * 16) * ld + cl;
#pragma unroll
                for (int bj = 0; bj < 2; ++bj) { f32x4 v0 = acc[ai][bj][m][0], v1 = acc[ai][bj][m][1];
                    if (ACT == 1) {
#pragma unroll
                        for (int k = 0; k < 4; ++k) { v0[k] = silu_f(v0[k]); v1[k] = silu_f(v1[k]); } }
                    if (ACT == 2) {
#pragma unroll
                        for (int k = 0; k < 4; ++k) { v0[k] = sigm_f(v0[k]); v1[k] = sigm_f(v1[k]); } }
                    *(u32x4*)(rowp + bj * HALF) = pack8(v0, v1); } }
    }
    __device__ __forceinline__ void operator()(const f32x4 (&acc)[2][2][4][2], const Unit& u, int wr, int wc, int fr, int fq) const {
        asm volatile("" : "+v"(fr), "+v"(fq));
        const int t = u.pn, row0 = u.pm * BM + wr * 64 + fr, cl = wc * 32 + 8 * fq;
        if (t < 2) plain<0>(acc, ZB + 256 * t, 512, row0, cl);
        else if (t < 6) {
#pragma unroll
            for (int ai = 0; ai < 2; ++ai)
#pragma unroll
                for (int m = 0; m < 4; ++m) { bf16_t* rowp = ZU + (size_t)(row0 + ai * HALF + m * 16) * 512 + 128 * (t - 2) + cl;
                    *(u32x4*)rowp = pack8(acc[ai][0][m][0] * acc[ai][1][m][0], acc[ai][0][m][1] * acc[ai][1][m][1]); }
        } else if (t < 10) {
            bf16_t* dst = (t < 8) ? RQ : RK; const float sc = (t < 8) ? 1.0f : 0.08838834764831845f;
            const int head = 2 * (t & 1) + (wc >> 1), d0 = cl & 63;
#pragma unroll
            for (int ai = 0; ai < 2; ++ai)
#pragma unroll
                for (int m = 0; m < 4; ++m) { const int row = row0 + ai * HALF + m * 16, pos = row < SEQ ? row : SEQ;
                    const f32x4* tp = (const f32x4*)(TABF + (size_t)pos * 64 + d0); const f32x4 c0 = tp[0], c1 = tp[1], c2 = tp[2], c3 = tp[3];
                    const f32x4 a0 = acc[ai][0][m][0], a1 = acc[ai][0][m][1], b0 = acc[ai][1][m][0], b1 = acc[ai][1][m][1];
                    f32x4 o10, o11, o20, o21;
                    o10[0] = (a0[0] * c0[0] - b0[0] * c0[1]) * sc; o20[0] = (b0[0] * c0[0] + a0[0] * c0[1]) * sc;
                    o10[1] = (a0[1] * c0[2] - b0[1] * c0[3]) * sc; o20[1] = (b0[1] * c0[2] + a0[1] * c0[3]) * sc;
                    o10[2] = (a0[2] * c1[0] - b0[2] * c1[1]) * sc; o20[2] = (b0[2] * c1[0] + a0[2] * c1[1]) * sc;
                    o10[3] = (a0[3] * c1[2] - b0[3] * c1[3]) * sc; o20[3] = (b0[3] * c1[2] + a0[3] * c1[3]) * sc;
                    o11[0] = (a1[0] * c2[0] - b1[0] * c2[1]) * sc; o21[0] = (b1[0] * c2[0] + a1[0] * c2[1]) * sc;
                    o11[1] = (a1[1] * c2[2] - b1[1] * c2[3]) * sc; o21[1] = (b1[1] * c2[2] + a1[1] * c2[3]) * sc;
                    o11[2] = (a1[2] * c3[0] - b1[2] * c3[1]) * sc; o21[2] = (b1[2] * c3[0] + a1[2] * c3[1]) * sc;
                    o11[3] = (a1[3] * c3[2] - b1[3] * c3[3]) * sc; o21[3] = (b1[3] * c3[2] + a1[3] * c3[3]) * sc;
                    bf16_t* rowp = dst + (size_t)row * 512 + head * 128 + d0;
                    *(u32x4*)rowp = pack8(o10, o11); *(u32x4*)(rowp + 64) = pack8(o20, o21); }
        } else if (t < 12) plain<0>(acc, RV + 256 * (t - 10), 512, row0, cl);
        else if (t < 14) plain<1>(acc, RG + 256 * (t - 12), 512, row0, cl);
        else if (t < 23) {
            const int g = (t - 14) / 3, k = (t - 14) % 3;
            if (k == 2) plain<0>(acc, AV + (size_t)g * MT * 256, 256, row0, cl);
            else {
                bf16_t* dst = (k == 0 ? AQ : AK) + (size_t)g * MT * 256; const float sc = (k == 0) ? 0.125f * LOG2E : 1.0f; const int head = wc;
#pragma unroll
                for (int ai = 0; ai < 2; ++ai)
#pragma unroll
                    for (int m = 0; m < 4; ++m) { const int row = row0 + ai * HALF + m * 16, pos = row < SEQ ? row : SEQ;
                        const f32x4 a0 = acc[ai][0][m][0], a1 = acc[ai][0][m][1], b0 = acc[ai][1][m][0], b1 = acc[ai][1][m][1];
                        bf16_t* rowp = dst + (size_t)row * 256 + head * 64;
                        if (fq == 0) {
                            const f32x4* tp = (const f32x4*)(TABP + (size_t)pos * 8); const f32x4 c0 = tp[0], c1 = tp[1], c2 = tp[2], c3 = tp[3];
                            f32x4 o10, o11, o20, o21;
                            o10[0] = (a0[0] * c0[0] - b0[0] * c0[1]) * sc; o20[0] = (b0[0] * c0[0] + a0[0] * c0[1]) * sc;
                            o10[1] = (a0[1] * c0[2] - b0[1] * c0[3]) * sc; o20[1] = (b0[1] * c0[2] + a0[1] * c0[3]) * sc;
                            o10[2] = (a0[2] * c1[0] - b0[2] * c1[1]) * sc; o20[2] = (b0[2] * c1[0] + a0[2] * c1[1]) * sc;
                            o10[3] = (a0[3] * c1[2] - b0[3] * c1[3]) * sc; o20[3] = (b0[3] * c1[2] + a0[3] * c1[3]) * sc;
                            o11[0] = (a1[0] * c2[0] - b1[0] * c2[1]) * sc; o21[0] = (b1[0] * c2[0] + a1[0] * c2[1]) * sc;
                            o11[1] = (a1[1] * c2[2] - b1[1] * c2[3]) * sc; o21[1] = (b1[1] * c2[2] + a1[1] * c2[3]) * sc;
                            o11[2] = (a1[2] * c3[0] - b1[2] * c3[1]) * sc; o21[2] = (b1[2] * c3[0] + a1[2] * c3[1]) * sc;
                            o11[3] = (a1[3] * c3[2] - b1[3] * c3[3]) * sc; o21[3] = (b1[3] * c3[2] + a1[3] * c3[3]) * sc;
                            *(u32x4*)rowp = pack8(o10, o11); *(u32x4*)(rowp + 8) = pack8(o20, o21);
                        } else {
                            *(u32x4*)(rowp + 8 + 8 * fq) = pack8(a0 * sc, a1 * sc); *(u32x4*)(rowp + 32 + 8 * fq) = pack8(b0 * sc, b1 * sc);
                        } }
            }
        } else plain<2>(acc, GATES + 256 * (t - 23), NGATE, row0, cl);
    }
};
template <class Epi, class Sched, bool ALIGN_EPI = false, bool SP2 = false>
__device__ __forceinline__ void gemm_phase(PG8_LAS unsigned char* lds, const Gemm g, const Sched& S, const Epi& E) {
    int tid_ = threadIdx.x; asm volatile("" : "+v"(tid_)); const int tid = tid_, wid = __builtin_amdgcn_readfirstlane(tid >> 6), lane = tid & 63, wr = wid >> 2, wc = wid & 3, fr = lane & 15, fq = lane >> 4;
    const int K = g.K, nt = K / BK;
    unsigned voffA[2], voffB[2];
#pragma unroll
    for (int i = 0; i < 2; ++i) { int R, C; stage_rc(tid * 16 + i * 8192, R, C); const int Rb = Epi::PERM ? ((R & ~31) + perm32(R & 31)) : R;
        voffA[i] = (unsigned)(R * K + C) * 2u; voffB[i] = (unsigned)(Rb * K + C) * 2u; }
    const size_t kstep = (size_t)(BK * 2);
    const size_t hstep = (size_t)HALF * K * 2;
    const size_t tstep = 2 * hstep;
    const unsigned ldsw = (unsigned)wid * 1024u;
    const int aoff = lds_byte(wr * 64 + fr, fq * 8), boff = lds_byte(wc * 32 + fr, fq * 8);
#define PG8_SA(b, h) (((b) * 2 + (h)) * HTB)
#define PG8_SB(b, h) ((4 + (b) * 2 + (h)) * HTB)
#define PG8_STAGE(bufoff, gbase, voff) do { _Pragma("unroll") for (int _i = 0; _i < 2; ++_i) \
        __builtin_amdgcn_global_load_lds((const unsigned*)((const char*)(gbase) + (voff)[_i]), (PG8_LAS unsigned*)(lds + (bufoff) + ldsw + _i * 8192), 16, 0, 0); } while (0)
#define PG8_LDA(dst, b, h) do { _Pragma("unroll") for (int m = 0; m < 4; ++m) _Pragma("unroll") for (int k = 0; k < 2; ++k) dst[m][k] = *(const PG8_LAS bf16x8*)(lds + PG8_SA(b, h) + aoff + m * 2048 + k * 1024); } while (0)
#define PG8_LDB(dst, b, h) do { _Pragma("unroll") for (int n = 0; n < 2; ++n) _Pragma("unroll") for (int k = 0; k < 2; ++k) dst[n][k] = *(const PG8_LAS bf16x8*)(lds + PG8_SB(b, h) + boff + n * 2048 + k * 1024); } while (0)
#define PG8_MMA(ai, bj, At, Bt) do { __builtin_amdgcn_s_setprio(1); _Pragma("unroll") for (int m = 0; m < 4; ++m) _Pragma("unroll") for (int n = 0; n < 2; ++n) _Pragma("unroll") for (int k = 0; k < 2; ++k) \
        acc[ai][bj][m][n] = __builtin_amdgcn_mfma_f32_16x16x32_bf16(Bt[n][k], At[m][k], acc[ai][bj][m][n], 0, 0, 0); __builtin_amdgcn_s_setprio(0); } while (0)
#define PG8_WAIT_V(n) asm volatile("s_waitcnt vmcnt(" #n ")" ::: "memory")
#define PG8_WAIT_L(n) asm volatile("s_waitcnt lgkmcnt(" #n ")" ::: "memory")
#define PG8_BAR __builtin_amdgcn_s_barrier()
#define PG8_SCHED __builtin_amdgcn_sched_barrier(0)
    Unit cur, nxt; int ui = 0;
    if (!S.next(0, cur)) return;
    f32x4 acc[2][2][4][2];
#pragma unroll
    for (int a = 0; a < 2; ++a)
#pragma unroll
        for (int b = 0; b < 2; ++b)
#pragma unroll
            for (int m = 0; m < 4; ++m)
#pragma unroll
                for (int n = 0; n < 2; ++n) acc[a][b][m][n] = (f32x4){0.f, 0.f, 0.f, 0.f};
    bf16x8 At[4][2], B0[2][2], B1[2][2];
    const char* cA = (const char*)g.A + (size_t)cur.pm * tstep; const char* cB = (const char*)g.Bt + (size_t)cur.pn * tstep;
    S.a_ready(cur);
    if constexpr (SP2) {
        PG8_STAGE(PG8_SB(0, 0), cB, voffB); PG8_STAGE(PG8_SB(0, 1), cB + hstep, voffB); PG8_STAGE(PG8_SA(0, 0), cA, voffA); PG8_STAGE(PG8_SA(0, 1), cA + hstep, voffA);
        if (wr == 1) PG8_BAR;
        PG8_WAIT_V(2); PG8_BAR;
        PG8_STAGE(PG8_SB(1, 0), cB + kstep, voffB); PG8_STAGE(PG8_SA(1, 0), cA + kstep, voffA); PG8_STAGE(PG8_SB(1, 1), cB + hstep + kstep, voffB);
        PG8_WAIT_V(6); PG8_BAR;
    } else {
        PG8_STAGE(PG8_SB(0, 0), cB, voffB); PG8_STAGE(PG8_SA(0, 0), cA, voffA); PG8_STAGE(PG8_SB(0, 1), cB + hstep, voffB); PG8_STAGE(PG8_SA(0, 1), cA + hstep, voffA);
        if (wr == 1) PG8_BAR;
        PG8_WAIT_V(4); PG8_BAR;
        PG8_STAGE(PG8_SB(1, 0), cB + kstep, voffB); PG8_STAGE(PG8_SA(1, 0), cA + kstep, voffA); PG8_STAGE(PG8_SB(1, 1), cB + hstep + kstep, voffB);
        PG8_WAIT_V(6); PG8_BAR;
    }
    for (;;) {
        const bool has_next = S.next(ui + 1, nxt);
        const char* nA = has_next ? (const char*)g.A + (size_t)nxt.pm * tstep : cA; const char* nB = has_next ? (const char*)g.Bt + (size_t)nxt.pn * tstep : cB;
        for (int t = 0; t < nt; t += 2) {
            const bool last = (t == nt - 2);
            const char* a1 = cA + (size_t)(t + 1) * kstep;
            const char* a2 = last ? nA : cA + (size_t)(t + 2) * kstep; const char* b2 = last ? nB : cB + (size_t)(t + 2) * kstep;
            const char* a3 = a2 + kstep; const char* b3 = b2 + kstep;
            if (last && has_next) S.a_ready(nxt);
            if constexpr (SP2) {
            PG8_LDB(B0, 0, 0); PG8_LDB(B1, 0, 1); PG8_SCHED; PG8_LDA(At, 0, 0); PG8_STAGE(PG8_SA(1, 1), a1 + hstep, voffA);
            PG8_WAIT_V(8); PG8_WAIT_L(0); PG8_BAR; PG8_MMA(0, 0, At, B0); PG8_MMA(0, 1, At, B1); PG8_BAR; PG8_SCHED;
            PG8_LDA(At, 0, 1); PG8_STAGE(PG8_SB(0, 0), b2, voffB); PG8_STAGE(PG8_SB(0, 1), b2 + hstep, voffB); PG8_STAGE(PG8_SA(0, 0), a2, voffA);
            PG8_WAIT_V(8); PG8_WAIT_L(0); PG8_BAR; PG8_MMA(1, 0, At, B0); PG8_MMA(1, 1, At, B1); PG8_BAR; PG8_SCHED;
            PG8_LDB(B0, 1, 0); PG8_LDB(B1, 1, 1); PG8_SCHED; PG8_LDA(At, 1, 0); PG8_STAGE(PG8_SA(0, 1), a2 + hstep, voffA);
            PG8_WAIT_V(8); PG8_WAIT_L(0); PG8_BAR; PG8_MMA(0, 0, At, B0); PG8_MMA(0, 1, At, B1); PG8_BAR; PG8_SCHED;
            PG8_LDA(At, 1, 1); PG8_STAGE(PG8_SB(1, 0), b3, voffB); PG8_STAGE(PG8_SB(1, 1), b3 + hstep, voffB); PG8_STAGE(PG8_SA(1, 0), a3, voffA);
            PG8_WAIT_V(8); PG8_WAIT_L(0); PG8_BAR; PG8_MMA(1, 0, At, B0); PG8_MMA(1, 1, At, B1); PG8_BAR; PG8_SCHED;
            } else {
            PG8_LDB(B0, 0, 0); PG8_SCHED; PG8_LDA(At, 0, 0); PG8_STAGE(PG8_SA(1, 1), a1 + hstep, voffA);
            PG8_WAIT_L(8); PG8_BAR; PG8_WAIT_L(0); PG8_MMA(0, 0, At, B0); PG8_BAR; PG8_SCHED;
            PG8_LDB(B1, 0, 1); PG8_STAGE(PG8_SB(0, 0), b2, voffB);
            PG8_BAR; PG8_WAIT_L(0); PG8_MMA(0, 1, At, B1); PG8_BAR;
            PG8_LDA(At, 0, 1); PG8_STAGE(PG8_SA(0, 0), a2, voffA);
            PG8_BAR; PG8_WAIT_L(0); PG8_MMA(1, 0, At, B0); PG8_BAR; PG8_SCHED;
            PG8_STAGE(PG8_SB(0, 1), b2 + hstep, voffB);
            PG8_WAIT_V(6); PG8_BAR; PG8_MMA(1, 1, At, B1); PG8_BAR;
            PG8_LDB(B0, 1, 0); PG8_SCHED; PG8_LDA(At, 1, 0); PG8_STAGE(PG8_SA(0, 1), a2 + hstep, voffA);
            PG8_WAIT_L(8); PG8_BAR; PG8_WAIT_L(0); PG8_MMA(0, 0, At, B0); PG8_BAR; PG8_SCHED;
            PG8_LDB(B1, 1, 1); PG8_STAGE(PG8_SB(1, 0), b3, voffB);
            PG8_BAR; PG8_WAIT_L(0); PG8_MMA(0, 1, At, B1); PG8_BAR;
            PG8_LDA(At, 1, 1); PG8_STAGE(PG8_SA(1, 0), a3, voffA);
            PG8_BAR; PG8_WAIT_L(0); PG8_MMA(1, 0, At, B0); PG8_BAR; PG8_SCHED;
            PG8_STAGE(PG8_SB(1, 1), b3 + hstep, voffB);
            PG8_WAIT_V(6); PG8_BAR; PG8_MMA(1, 1, At, B1); PG8_BAR;
            }
        }
        if constexpr (ALIGN_EPI) { if (wr == 0) PG8_BAR; }
        if constexpr (!Epi::AFTER_DRAIN) { E(acc, cur, wr, wc, fr, fq); S.done(cur); }
        if (!has_next) break;
#pragma unroll
        for (int a = 0; a < 2; ++a)
#pragma unroll
            for (int b = 0; b < 2; ++b)
#pragma unroll
                for (int m = 0; m < 4; ++m)
#pragma unroll
                    for (int n = 0; n < 2; ++n) acc[a][b][m][n] = (f32x4){0.f, 0.f, 0.f, 0.f};
        cur = nxt; cA = nA; cB = nB; ++ui;
        if constexpr (ALIGN_EPI) { if (wr == 1) PG8_BAR; }
    }
    PG8_WAIT_V(0);
    if constexpr (!ALIGN_EPI) { if (wr == 0) PG8_BAR; }
    PG8_BAR;
    if constexpr (Epi::AFTER_DRAIN) { E.fused(acc, cur, wr, wc, fr, fq, lds, wid, lane); S.done(cur); }
#undef PG8_SA
#undef PG8_SB
#undef PG8_STAGE
#undef PG8_LDA
#undef PG8_LDB
#undef PG8_MMA
#undef PG8_WAIT_V
#undef PG8_WAIT_L
#undef PG8_BAR
#undef PG8_SCHED
}
}
typedef GAS unsigned gu32;
typedef GAS unsigned long long gu64;
#define RLX_AGENT __ATOMIC_RELAXED, __HIP_MEMORY_SCOPE_AGENT
#define LDS_WAIT() asm volatile("s_waitcnt lgkmcnt(0)" ::: "memory")
#define VM_WAIT() asm volatile("s_waitcnt vmcnt(0)" ::: "memory")
constexpr int NWAVES = 8;
constexpr int RING_BYTES = 131072, LDSCTL_OFF = 147456 - 512, LDS_BYTES = 147456;
#define XB_TMO      128
#define XB_XCNT(j)  (256  + 64 * (j))
#define XB_XSUB(j)  (1280 + 64 * (j))
#define XB_XGEN(j)  (2304 + 64 * (j))
#define XB_TOP      3328
#define XB_TOPGEN   3392
#define XCD_BAR_WORDS 3456
#define XB_SPIN_CAP (1u << 18)

__device__ __forceinline__ unsigned xb_ld(unsigned* p)              { return __hip_atomic_load(p, __ATOMIC_RELAXED, __HIP_MEMORY_SCOPE_AGENT); }
__device__ __forceinline__ unsigned xb_add(unsigned* p, unsigned v) { return __hip_atomic_fetch_add(p, v, __ATOMIC_RELAXED, __HIP_MEMORY_SCOPE_AGENT); }
__device__ __forceinline__ unsigned xb_xcc_id() { return (unsigned)__builtin_amdgcn_s_getreg((3 << 11) | 20) & 0xFu; }
#define XB_SPIN(cond, bar) do { unsigned _sp = 0; while (cond) { __builtin_amdgcn_s_sleep(1); \
    if ((++_sp & 255u) == 0u) { if (xb_ld(&(bar)[XB_TMO])) break; if (_sp > XB_SPIN_CAP) { atomicAdd(&(bar)[XB_TMO], 1u); break; } } } } while (0)

struct XcdBarrier {
    unsigned* bar; unsigned x;
    volatile LAS unsigned* st;
};

__device__ __forceinline__ XcdBarrier xcd_barrier_post(unsigned* bar, volatile LAS unsigned* st) {
    XcdBarrier b; b.bar = bar; b.x = xb_xcc_id(); b.st = st;
    if (threadIdx.x == 0) (void)xb_add(&bar[XB_XCNT(b.x)], 1u);
    return b;
}
__device__ __forceinline__ void xcd_barrier_complete(unsigned* bar, unsigned x, unsigned& nloc, unsigned& nx) {
    const unsigned G = gridDim.x * gridDim.y * gridDim.z;
    unsigned sum, cnt, mine, sp = 0u;
    for (;;) {
        sum = 0u; cnt = 0u; mine = 0u;
#pragma unroll
        for (unsigned j = 0; j < 16; ++j) { const unsigned c = xb_ld(&bar[XB_XCNT(j)]); sum += c; cnt += (c > 0u) ? 1u : 0u; mine = (j == x) ? c : mine; }
        if (sum == G) break;
        __builtin_amdgcn_s_sleep(1);
        if ((++sp & 255u) == 0u) { if (xb_ld(&bar[XB_TMO])) break; if (sp > XB_SPIN_CAP) { atomicAdd(&bar[XB_TMO], 1u); break; } }
    }
    nloc = mine > 0u ? mine : 1u; nx = cnt > 0u ? cnt : 1u;
}

__device__ __forceinline__ void xcd_barrier(const XcdBarrier& b) {
    asm volatile("s_waitcnt vmcnt(0)" ::: "memory");
    __syncthreads();
    if (threadIdx.x == 0) {
        unsigned* bar = b.bar;
        __builtin_amdgcn_s_waitcnt(0);
        unsigned nloc = b.st[0], nx = b.st[1];
        if (nloc == 0u) { xcd_barrier_complete(bar, b.x, nloc, nx); b.st[0] = nloc; b.st[1] = nx; }
        const unsigned old = xb_add(&bar[XB_XSUB(b.x)], 1u);
        const unsigned gen = old / nloc;
        if (old + 1u == (gen + 1u) * nloc) {
            __builtin_amdgcn_fence(__ATOMIC_RELEASE, "agent");
            asm volatile("s_waitcnt vmcnt(0)" ::: "memory");
            const unsigned og = xb_add(&bar[XB_TOP], 1u);
            const unsigned tg = og / nx;
            if (og + 1u == (tg + 1u) * nx) xb_add(&bar[XB_TOPGEN], 1u);
            else XB_SPIN(xb_ld(&bar[XB_TOPGEN]) == tg, bar);
            __builtin_amdgcn_fence(__ATOMIC_ACQUIRE, "agent");
            xb_add(&bar[XB_XGEN(b.x)], 1u);
            asm volatile("s_waitcnt vmcnt(0)" ::: "memory");
        } else {
            XB_SPIN(xb_ld(&bar[XB_XGEN(b.x)]) == gen, bar);
            __builtin_amdgcn_fence(__ATOMIC_ACQUIRE, "agent");
            asm volatile("s_waitcnt vmcnt(0)" ::: "memory");
        }
    }
    __syncthreads();
}
#define INP(F, k) ((const float*)(const GAS float*)(*(const float* const __attribute__((address_space(4)))*)((F).kp + 8 * (k))))
#define LAUNDER_FRAME(F) do { GAS unsigned char* w_ = (GAS unsigned char*)(F).ws; GAS float* o_ = (GAS float*)(F).out; asm volatile("" : "+s"(w_), "+s"(o_), "+s"((F).kp), "+v"((F).tid)); \
    (F).ws = (unsigned char*)w_; (F).out = (float*)o_; (F).lane = (F).tid & 63; (F).wave = __builtin_amdgcn_readfirstlane((F).tid >> 6); } while (0)
struct Frame {
    LAS unsigned char* lds;
    int tid, lane, wave, vcu, G, bx;
    unsigned char* ws; float* out;
    const __attribute__((address_space(4))) unsigned char* kp;
};
__device__ __forceinline__ float wave_sum(float v) {
#pragma unroll
    for (int o = 1; o < 64; o <<= 1) v += __shfl_xor(v, o);
    return v;
}
template <int MAP> __device__ __forceinline__ int dmap(int n) {
    if (MAP == 0) return n;
    if (MAP == 1) { const int up = n >= DFF ? 1 : 0, c = n - up * DFF; return (c >> 7) * 256 + up * 128 + (c & 127); }
    if (n < 512) return n;
    if (n < 1536) { const int hh = n >= 1024 ? 1 : 0, c = n - 512 - hh * 512; return 512 + (c >> 7) * 256 + hh * 128 + (c & 127); }
    if (n < 2560) { const int base = n < 2048 ? 1536 : 2048, c = n - base, head = c >> 7, half = (c >> 6) & 1, d = c & 63; return base + (head >> 1) * 256 + half * 128 + (head & 1) * 64 + d; }
    if (n < 3584) return n;
    { const int c = n - 3584, grp = c >> 8, k = grp % 3, cc = c & 255; if (k == 2) return n;
      const int h = cc >> 6, dim = cc & 63; int jj;
      if (dim < 8) jj = h * 32 + dim; else if (dim < 16) jj = 128 + h * 32 + (dim - 8); else if (dim < 40) jj = h * 32 + 8 + (dim - 16); else jj = 128 + h * 32 + 8 + (dim - 40);
      return 3584 + grp * 256 + jj; }
}
template <int MAP> __device__ __forceinline__ void tr_item(const float* W, int K, int N, bf16* WT, int row_off, LAS float* scr, int item, int lane) {
    const int nblk = N / 32, kb = item / nblk, nb = item % nblk, k0 = 64 * kb, n0 = 32 * nb;
#pragma unroll 8
    for (int i = 0; i < 32; ++i) { const int kk = 2 * i + (lane >> 5); scr[kk * 33 + (lane & 31)] = W[(size_t)(k0 + kk) * N + n0 + (lane & 31)]; }
    LDS_WAIT(); asm volatile("" ::: "memory");
    const int c = lane & 7;
#pragma unroll
    for (int j = 0; j < 4; ++j) { const int n = (lane >> 3) + 8 * j; const LAS float* s = scr + (8 * c) * 33 + n;
        v4u o; o.x = pk2(s[0 * 33], s[1 * 33]); o.y = pk2(s[2 * 33], s[3 * 33]); o.z = pk2(s[4 * 33], s[5 * 33]); o.w = pk2(s[6 * 33], s[7 * 33]);
        *(GAS v4u*)(WT + (size_t)(row_off + dmap<MAP>(n0 + n)) * K + k0 + 8 * c) = o; }
    LDS_WAIT(); asm volatile("" ::: "memory");
}
__device__ __forceinline__ void rms_row_to_bf16(const float* xrow, const float* g, bf16* hrow, int lane) {
    const GAS f32x4* xr = (const GAS f32x4*)xrow + lane; const GAS f32x4* gr = (const GAS f32x4*)g + lane;
    f32x4 v[4]; float s = 0.f;
#pragma unroll
    for (int j = 0; j < 4; ++j) { v[j] = xr[64 * j]; s += (v[j].x * v[j].x + v[j].y * v[j].y) + (v[j].z * v[j].z + v[j].w * v[j].w); }
    const float rstd = 1.f / sqrtf(wave_sum(s) * (1.f / DM) + EPS);
    GAS v2u* o8 = (GAS v2u*)hrow + lane;
#pragma unroll
    for (int j = 0; j < 4; ++j) { const f32x4 gg = gr[64 * j]; v2u w; w.x = pk2(v[j].x * rstd * gg.x, v[j].y * rstd * gg.y); w.y = pk2(v[j].z * rstd * gg.z, v[j].w * rstd * gg.w); o8[64 * j] = w; }
}
__device__ __forceinline__ void p0_prologue(Frame& F) {
    LAS float* scr = (LAS float*)(F.lds + F.wave * 16384);
    const int gw = F.vcu * NWAVES + F.wave, NGW = F.G * NWAVES;
    constexpr int I_GU = (DM / 64) * (NGU / 32), I_D = (DFF / 64) * (DM / 32), I_IN = (DM / 64) * (NIN / 32), I_G = (DM / 64) * (NGATE / 32), I_CO = (CONVD / 64) * (DM / 32), I_AO = (ATTD / 64) * (DM / 32),
                  I_WO = (DM / 64) * (DM / 32), I_PP = (PLE / 64) * (DM / 32);
    constexpr int I_LAYER = 2 * I_GU + 2 * I_D + I_IN + I_G + 2 * I_CO + I_AO + 2 * I_WO + I_PP;
    for (int it0 = gw; it0 < DEPTH * I_LAYER; it0 += NGW) {
        const int l = it0 / I_LAYER; int r = it0 % I_LAYER; unsigned char* wl = F.ws + WS_W + (size_t)l * WL_SIZE;
        if (r < I_GU) { tr_item<1>(INP(F, 10) + (size_t)l * DM * NGU, DM, NGU, (bf16*)(wl + WL_GU1), 0, scr, r, F.lane); continue; } r -= I_GU;
        if (r < I_GU) { tr_item<1>(INP(F, 20) + (size_t)l * DM * NGU, DM, NGU, (bf16*)(wl + WL_GU2), 0, scr, r, F.lane); continue; } r -= I_GU;
        if (r < I_D) { tr_item<0>(INP(F, 11) + (size_t)l * DFF * DM, DFF, DM, (bf16*)(wl + WL_D1), 0, scr, r, F.lane); continue; } r -= I_D;
        if (r < I_D) { tr_item<0>(INP(F, 21) + (size_t)l * DFF * DM, DFF, DM, (bf16*)(wl + WL_D2), 0, scr, r, F.lane); continue; } r -= I_D;
        if (r < I_IN) { tr_item<2>(INP(F, 12) + (size_t)l * DM * NIN, DM, NIN, (bf16*)(wl + WL_IN), 0, scr, r, F.lane); continue; } r -= I_IN;
        if (r < I_G) { tr_item<0>(INP(F, 18) + (size_t)l * DM * NGATE, DM, NGATE, (bf16*)(wl + WL_IN), NIN, scr, r, F.lane); continue; } r -= I_G;
        if (r < I_CO) { tr_item<0>(INP(F, 15) + (size_t)l * CONVD * DM, CONVD, DM, (bf16*)(wl + WL_CO), 0, scr, r, F.lane); continue; } r -= I_CO;
        if (r < I_CO) { tr_item<0>(INP(F, 16) + (size_t)l * RETD * DM, RETD, DM, (bf16*)(wl + WL_RO), 0, scr, r, F.lane); continue; } r -= I_CO;
        if (r < I_AO) { tr_item<0>(INP(F, 17) + (size_t)l * ATTD * DM, ATTD, DM, (bf16*)(wl + WL_AO), 0, scr, r, F.lane); continue; } r -= I_AO;
        if (r < I_WO) { tr_item<0>(INP(F, 19) + (size_t)l * DM * DM, DM, DM, (bf16*)(wl + WL_WO), 0, scr, r, F.lane); continue; } r -= I_WO;
        if (r < I_WO) { tr_item<0>(INP(F, 22) + (size_t)l * DM * DM, DM, DM, (bf16*)(wl + WL_PG), 0, scr, r, F.lane); continue; } r -= I_WO;
        tr_item<0>(INP(F, 23) + (size_t)l * PLE * DM, PLE, DM, (bf16*)(wl + WL_PP), 0, scr, r, F.lane);
    }
    float* X = (float*)(F.ws + WS_X); bf16* H = (bf16*)(F.ws + WS_H);
    for (int m = gw; m < MT; m += NGW) {
        GAS f32x4* xo = (GAS f32x4*)(X + (size_t)m * DM) + F.lane;
        if (m < MV) { const float* src = m < SEQ ? INP(F, 0) + (size_t)m * DM : INP(F, 1) + (size_t)(m - SEQ) * DM;
            const GAS f32x4* xr = (const GAS f32x4*)src + F.lane;
#pragma unroll
            for (int j = 0; j < 4; ++j) xo[64 * j] = xr[64 * j];
            rms_row_to_bf16(src, INP(F, 9), H + (size_t)m * DM, F.lane);
        } else {
#pragma unroll
            for (int j = 0; j < 4; ++j) xo[64 * j] = (f32x4){0.f, 0.f, 0.f, 0.f};
            GAS v2u* o8 = (GAS v2u*)(H + (size_t)m * DM) + F.lane;
#pragma unroll
            for (int j = 0; j < 4; ++j) o8[64 * j] = (v2u){0u, 0u};
        }
    }
    bf16* PB = (bf16*)(F.ws + WS_PLEB);
    for (int it = gw; it < DEPTH * MT; it += NGW) { const int l = it / MT, m = it % MT; f32x4 v = (f32x4){0.f, 0.f, 0.f, 0.f};
        if (m < SEQ) v = ((const GAS f32x4*)(INP(F, 7) + ((size_t)l * SEQ + m) * PLE))[F.lane];
        else if (m < MV) v = ((const GAS f32x4*)(INP(F, 8) + ((size_t)l * NBATCH + (m - SEQ)) * PLE))[F.lane];
        ((GAS v2u*)(PB + ((size_t)l * MT + m) * PLE))[F.lane] = (v2u){pk2(v.x, v.y), pk2(v.z, v.w)}; }
    f32x2* TF = (f32x2*)(F.ws + WS_TABF); f32x2* TP = (f32x2*)(F.ws + WS_TABP);
    const int gt = F.vcu * NWAVES * 64 + F.wave * 64 + F.lane, NGT = NGW * 64;
    for (int i = gt; i < (SEQ + 1) * 64; i += NGT) { const int pos = i >> 6, d = i & 63; const float inv = expf(-(float)d * (9.210340371976184f / 64.0f)); const float ang = (float)pos * inv; float s, c; sincosf(ang, &s, &c); TF[i] = (f32x2){c, s}; }
    for (int i = gt; i < (SEQ + 1) * 8; i += NGT) { const int pos = i >> 3, d = i & 7; const float inv = expf(-(float)d * (13.122363377404328f / 8.0f)); const float ang = (float)pos * inv; float s, c; sincosf(ang, &s, &c); TP[i] = (f32x2){c, s}; }
    { bf16* CY = (bf16*)(F.ws + WS_CONVY); bf16* RY = (bf16*)(F.ws + WS_RETY); bf16* AY = (bf16*)(F.ws + WS_ATTY);
      for (int i = gt; i < (MT - MV) * 512 / 8; i += NGT) { ((GAS v4u*)(CY + (size_t)MV * 512))[i] = (v4u){0u, 0u, 0u, 0u}; ((GAS v4u*)(RY + (size_t)MV * 512))[i] = (v4u){0u, 0u, 0u, 0u}; }
      for (int i = gt; i < (MT - MV) * 256 / 8; i += NGT) ((GAS v4u*)(AY + (size_t)MV * 256))[i] = (v4u){0u, 0u, 0u, 0u}; }
}
__device__ __forceinline__ void norm_phase(Frame& F, float alpha, const float* gA, const float* gB, bool final) {
    const int gw = F.vcu * NWAVES + F.wave, NGW = F.G * NWAVES;
    float* X = (float*)(F.ws + WS_X); const float* Fb = (const float*)(F.ws + WS_F); bf16* H = (bf16*)(F.ws + WS_H);
    const GAS f32x4* ga = (const GAS f32x4*)gA + F.lane; const GAS f32x4* gb = (const GAS f32x4*)gB + F.lane;
    for (int m = gw; m < MT; m += NGW) {
        const GAS f32x4* fr = (const GAS f32x4*)(Fb + (size_t)m * DM) + F.lane; GAS f32x4* xr = (GAS f32x4*)(X + (size_t)m * DM) + F.lane;
        f32x4 f[4], x[4]; float s = 0.f;
#pragma unroll
        for (int j = 0; j < 4; ++j) { f[j] = fr[64 * j]; x[j] = xr[64 * j]; s += (f[j].x * f[j].x + f[j].y * f[j].y) + (f[j].z * f[j].z + f[j].w * f[j].w); }
        const float rstd = alpha / sqrtf(wave_sum(s) * (1.f / DM) + EPS); float s2 = 0.f;
#pragma unroll
        for (int j = 0; j < 4; ++j) { x[j] = x[j] + f[j] * ga[64 * j] * rstd; s2 += (x[j].x * x[j].x + x[j].y * x[j].y) + (x[j].z * x[j].z + x[j].w * x[j].w); }
        if (final) { if (m < MV) { GAS f32x4* o = (GAS f32x4*)(F.out + (size_t)m * DM) + F.lane;
#pragma unroll
                for (int j = 0; j < 4; ++j) o[64 * j] = x[j]; }
        } else {
#pragma unroll
            for (int j = 0; j < 4; ++j) xr[64 * j] = x[j];
            const float r2 = 1.f / sqrtf(wave_sum(s2) * (1.f / DM) + EPS);
            GAS v2u* o8 = (GAS v2u*)(H + (size_t)m * DM) + F.lane;
#pragma unroll
            for (int j = 0; j < 4; ++j) { const f32x4 gg = gb[64 * j]; v2u w; w.x = pk2(x[j].x * r2 * gg.x, x[j].y * r2 * gg.y); w.y = pk2(x[j].z * r2 * gg.z, x[j].w * r2 * gg.w); o8[64 * j] = w; }
        }
    }
}
typedef short v4i16_t __attribute__((ext_vector_type(4)));
typedef LAS const char* lds_cptr;
__device__ __forceinline__ s16x4 vtr(const LAS bf16* p) { return __builtin_bit_cast(s16x4, __builtin_amdgcn_ds_read_tr16_b64_v4i16((LAS v4i16_t*)p)); }
__device__ __forceinline__ bf16x8 cat8(s16x4 lo, s16x4 hi) { return (bf16x8){lo[0], lo[1], lo[2], lo[3], hi[0], hi[1], hi[2], hi[3]}; }
__device__ __forceinline__ bf16x8 pk8(f32x4 a, f32x4 b) { v4u w; w.x = pk2(a[0], a[1]); w.y = pk2(a[2], a[3]); w.z = pk2(b[0], b[1]); w.w = pk2(b[2], b[3]); return __builtin_bit_cast(bf16x8, w); }
#define MFMA16(a, b, c) __builtin_amdgcn_mfma_f32_16x16x32_bf16((a), (b), (c), 0, 0, 0)
constexpr int KROW = 72;
constexpr int RROW = 136;
__device__ __forceinline__ float ret_log2g(int h) { return log2f(1.0f - exp2f(-5.0f - (float)h)); }

__device__ __forceinline__ void attn_unit(const Frame& F0, int g, int h, int r, int nb) {
    Frame F = F0; LAUNDER_FRAME(F);
    const int dil = (g == 0) ? 1 : (g == 1 ? 4 : 16);
    const bf16* AQ = (const bf16*)(F.ws + WS_AQ) + (size_t)g * MT * 256 + h * 64;
    const bf16* AK = (const bf16*)(F.ws + WS_AK) + (size_t)g * MT * 256 + h * 64;
    const bf16* AV = (const bf16*)(F.ws + WS_AV) + (size_t)g * MT * 256 + h * 64;
    bf16* AO = (bf16*)(F.ws + WS_AO) + (size_t)g * MT * 256 + h * 64;
    float* LSE = (float*)(F.ws + WS_LSE) + (size_t)g * MT * 4 + h;
    LAS bf16* Ks = (LAS bf16*)F.lds; LAS bf16* Vs = Ks + 256 * KROW;
    const int lane = F.lane, w = F.wave, l15 = lane & 15, g4 = lane >> 4;
    __syncthreads();
#pragma unroll
    for (int i = 0; i < 4; ++i) { const int c = F.tid + 512 * i, row = c >> 3, ch = c & 7, kj = nb * 128 - 128 + row;
        v4u kv = (v4u){0u, 0u, 0u, 0u}, vv = kv;
        if (kj >= 0) { const size_t pos = (size_t)kj * dil + r; kv = *(const GAS v4u*)(AK + pos * 256 + ch * 8); vv = *(const GAS v4u*)(AV + pos * 256 + ch * 8); }
        *(LAS v4u*)(Ks + row * KROW + ch * 8) = kv; *(LAS v4u*)(Vs + row * KROW + ch * 8) = vv; }
    const int iq = 16 * w + l15; const size_t posq = (size_t)(nb * 128 + iq) * dil + r;
    bf16x8 qf[2];
    qf[0] = *(const GAS bf16x8*)(AQ + posq * 256 + 8 * g4); qf[1] = *(const GAS bf16x8*)(AQ + posq * 256 + 32 + 8 * g4);
    __syncthreads();
    const int kt0 = w < 6 ? w : 6;
    f32x4 sc[10];
#pragma unroll
    for (int T = 0; T < 10; ++T) { const LAS bf16* kp = Ks + (16 * (kt0 + T) + l15) * KROW + 8 * g4;
        const bf16x8 a0 = *(const LAS bf16x8*)kp, a1 = *(const LAS bf16x8*)(kp + 32);
        sc[T] = MFMA16(a0, qf[0], ((f32x4){0.f, 0.f, 0.f, 0.f})); sc[T] = MFMA16(a1, qf[1], sc[T]); }
    float mx = -INFINITY;
#pragma unroll
    for (int T = 0; T < 10; ++T)
#pragma unroll
        for (int k = 0; k < 4; ++k) { const int jj = 16 * (kt0 + T) + 4 * g4 + k; const bool ok = (jj >= iq) && (jj <= iq + 128) && (nb > 0 || jj >= 128);
            sc[T][k] = ok ? sc[T][k] : -INFINITY; mx = fmaxf(mx, sc[T][k]); }
    mx = fmaxf(mx, __shfl_xor(mx, 16)); mx = fmaxf(mx, __shfl_xor(mx, 32));
    float sum = 0.f;
#pragma unroll
    for (int T = 0; T < 10; ++T)
#pragma unroll
        for (int k = 0; k < 4; ++k) { sc[T][k] = __builtin_amdgcn_exp2f(sc[T][k] - mx); sum += sc[T][k]; }
    sum += __shfl_xor(sum, 16); sum += __shfl_xor(sum, 32);
    f32x4 o[4];
#pragma unroll
    for (int t = 0; t < 4; ++t) o[t] = (f32x4){0.f, 0.f, 0.f, 0.f};
    const int q_ = l15 >> 2, p_ = l15 & 3;
#pragma unroll
    for (int s = 0; s < 5; ++s) { const bf16x8 pf = pk8(sc[2 * s], sc[2 * s + 1]); const LAS bf16* vp = Vs + (16 * (kt0 + 2 * s) + 4 * g4 + q_) * KROW + 4 * p_;
#pragma unroll
        for (int t = 0; t < 4; ++t) { const s16x4 lo = vtr(vp + 16 * t), hi = vtr(vp + 16 * KROW + 16 * t); o[t] = MFMA16(pf, cat8(lo, hi), o[t]); } }
    const float inv = 1.0f / sum;
#pragma unroll
    for (int k = 0; k < 4; ++k) { const float ik = __shfl(inv, 4 * g4 + k); const size_t pos = (size_t)(nb * 128 + 16 * w + 4 * g4 + k) * dil + r;
#pragma unroll
        for (int t = 0; t < 4; ++t) AO[pos * 256 + 16 * t + l15] = (bf16)f2bf(o[t][k] * ik); }
    if (g4 == 0) LSE[posq * 4] = (mx + __builtin_amdgcn_logf(sum)) * LN2;
}

__device__ __forceinline__ void retkv_item(const Frame& F0, int n, int h) {
    Frame F = F0; LAUNDER_FRAME(F);
    const bf16* RK = (const bf16*)(F.ws + WS_RK) + (size_t)(128 * n) * 512 + 128 * h; const bf16* RV = (const bf16*)(F.ws + WS_RV) + (size_t)(128 * n) * 512 + 128 * h;
    float* KVC = (float*)(F.ws + WS_KVC) + (size_t)(n * 4 + h) * 16384;
    LAS bf16* Ks = (LAS bf16*)F.lds; LAS bf16* Vs = Ks + 128 * RROW;
    const int lane = F.lane, w = F.wave, l15 = lane & 15, g4 = lane >> 4; const float lg = ret_log2g(h);
    __syncthreads();
#pragma unroll
    for (int i = 0; i < 4; ++i) { const int c = F.tid + 512 * i, row = c >> 4, ch = c & 15;
        const v4u kv = *(const GAS v4u*)(RK + (size_t)row * 512 + ch * 8), vv = *(const GAS v4u*)(RV + (size_t)row * 512 + ch * 8);
        const float kw = __builtin_amdgcn_exp2f((float)(127 - row) * lg);
        v4u ks; ks.x = pk2(bflo(kv.x) * kw, bfhi(kv.x) * kw); ks.y = pk2(bflo(kv.y) * kw, bfhi(kv.y) * kw); ks.z = pk2(bflo(kv.z) * kw, bfhi(kv.z) * kw); ks.w = pk2(bflo(kv.w) * kw, bfhi(kv.w) * kw);
        *(LAS v4u*)(Ks + row * RROW + ch * 8) = ks; *(LAS v4u*)(Vs + row * RROW + ch * 8) = vv; }
    __syncthreads();
    f32x4 acc[8];
#pragma unroll
    for (int t = 0; t < 8; ++t) acc[t] = (f32x4){0.f, 0.f, 0.f, 0.f};
    const int q_ = l15 >> 2, p_ = l15 & 3;
#pragma unroll
    for (int s = 0; s < 4; ++s) { const LAS bf16* vp = Vs + (32 * s + 4 * g4 + q_) * RROW + 16 * w + 4 * p_; const bf16x8 af = cat8(vtr(vp), vtr(vp + 16 * RROW));
        const LAS bf16* kp = Ks + (32 * s + 4 * g4 + q_) * RROW + 4 * p_;
#pragma unroll
        for (int t = 0; t < 8; ++t) acc[t] = MFMA16(af, cat8(vtr(kp + 16 * t), vtr(kp + 16 * RROW + 16 * t)), acc[t]); }
#pragma unroll
    for (int t = 0; t < 8; ++t)
#pragma unroll
        for (int k = 0; k < 4; ++k) KVC[(16 * w + 4 * g4 + k) * 128 + 16 * t + l15] = acc[t][k];
}
__device__ __forceinline__ void retscan_phase(Frame& F, int l) {
    if (F.tid >= 256) return;
    const float* KVC = (const float*)(F.ws + WS_KVC); bf16* SB = (bf16*)(F.ws + WS_SB); float* outp = F.out + OUT_RETP + (size_t)l * 65536;
    for (int idx = F.vcu * 256 + F.tid; idx < 65536; idx += F.G * 256) { const int h = idx >> 14, e = (idx >> 7) & 127, d = idx & 127;
        const float gc = exp2f(128.0f * ret_log2g(h)); float s = 0.f;
#pragma unroll 8
        for (int n = 0; n < 128; ++n) { SB[(size_t)n * 65536 + idx] = (bf16)f2bf(s); s = s * gc + KVC[(size_t)n * 65536 + idx]; }
        outp[h * 16384 + d * 128 + e] = s; }
}
__device__ __forceinline__ void retout_item(const Frame& F0, int n, int h) {
    Frame F = F0; LAUNDER_FRAME(F);
    const size_t rowb = (size_t)(128 * n);
    const bf16* RQ = (const bf16*)(F.ws + WS_RQ) + rowb * 512 + 128 * h; const bf16* RK = (const bf16*)(F.ws + WS_RK) + rowb * 512 + 128 * h;
    const bf16* RV = (const bf16*)(F.ws + WS_RV) + rowb * 512 + 128 * h; const bf16* RG = (const bf16*)(F.ws + WS_RG) + rowb * 512 + 128 * h;
    const bf16* SB = (const bf16*)(F.ws + WS_SB) + (size_t)(n * 4 + h) * 16384; bf16* RY = (bf16*)(F.ws + WS_RETY) + rowb * 512 + 128 * h;
    LAS bf16* Ks = (LAS bf16*)F.lds; LAS bf16* Vs = Ks + 128 * RROW; LAS bf16* Ss = Vs + 128 * RROW;
    const int lane = F.lane, w = F.wave, l15 = lane & 15, g4 = lane >> 4; const float lg = ret_log2g(h);
    __syncthreads();
#pragma unroll
    for (int i = 0; i < 4; ++i) { const int c = F.tid + 512 * i, row = c >> 4, ch = c & 15;
        *(LAS v4u*)(Ks + row * RROW + ch * 8) = *(const GAS v4u*)(RK + (size_t)row * 512 + ch * 8);
        *(LAS v4u*)(Vs + row * RROW + ch * 8) = *(const GAS v4u*)(RV + (size_t)row * 512 + ch * 8);
        *(LAS v4u*)(Ss + row * RROW + ch * 8) = *(const GAS v4u*)(SB + (size_t)row * 128 + ch * 8); }
    const int iq = 16 * w + l15;
    bf16x8 qf[4];
#pragma unroll
    for (int s = 0; s < 4; ++s) qf[s] = *(const GAS bf16x8*)(RQ + (size_t)iq * 512 + 32 * s + 8 * g4);
    __syncthreads();
    const int nT = (w | 1) + 1;
    f32x4 sc[8];
#pragma unroll
    for (int T = 0; T < 8; ++T) { sc[T] = (f32x4){0.f, 0.f, 0.f, 0.f};
        if (T < nT) { const LAS bf16* kp = Ks + (16 * T + l15) * RROW + 8 * g4;
#pragma unroll
            for (int s = 0; s < 4; ++s) sc[T] = MFMA16(*(const LAS bf16x8*)(kp + 32 * s), qf[s], sc[T]);
#pragma unroll
            for (int k = 0; k < 4; ++k) { const int j = 16 * T + 4 * g4 + k; sc[T][k] = (iq >= j) ? sc[T][k] * __builtin_amdgcn_exp2f((float)(iq - j) * lg) : 0.f; } } }
    f32x4 oa[8];
#pragma unroll
    for (int t = 0; t < 8; ++t) oa[t] = (f32x4){0.f, 0.f, 0.f, 0.f};
    const int q_ = l15 >> 2, p_ = l15 & 3;
#pragma unroll
    for (int s = 0; s < 4; ++s) { if (2 * s < nT) { const bf16x8 pf = pk8(sc[2 * s], sc[2 * s + 1]); const LAS bf16* vp = Vs + (32 * s + 4 * g4 + q_) * RROW + 4 * p_;
#pragma unroll
        for (int t = 0; t < 8; ++t) oa[t] = MFMA16(pf, cat8(vtr(vp + 16 * t), vtr(vp + 16 * RROW + 16 * t)), oa[t]); }
        asm volatile("" ::: "memory"); }
    { const float qw = __builtin_amdgcn_exp2f((float)(iq + 1) * lg);
#pragma unroll
      for (int s = 0; s < 4; ++s) { const v4u qq = __builtin_bit_cast(v4u, qf[s]); v4u o;
#pragma unroll
          for (int k = 0; k < 4; ++k) o[k] = pk2(bflo(qq[k]) * qw, bfhi(qq[k]) * qw);
          qf[s] = __builtin_bit_cast(bf16x8, o); } }
#pragma unroll
    for (int s = 0; s < 4; ++s) { const LAS bf16* sp = Ss + l15 * RROW + 32 * s + 8 * g4;
#pragma unroll
        for (int t = 0; t < 8; ++t) oa[t] = MFMA16(qf[s], *(const LAS bf16x8*)(sp + 16 * t * RROW), oa[t]);
        asm volatile("" ::: "memory"); }
#pragma unroll
    for (int k = 0; k < 4; ++k) { const int il = 16 * w + 4 * g4 + k;
        float v[8], s1 = 0.f;
#pragma unroll
        for (int t = 0; t < 8; ++t) { v[t] = oa[t][k]; s1 += v[t]; }
        s1 += __shfl_xor(s1, 1); s1 += __shfl_xor(s1, 2); s1 += __shfl_xor(s1, 4); s1 += __shfl_xor(s1, 8);
        const float mu = s1 * (1.0f / 128.0f); float s2 = 0.f;
#pragma unroll
        for (int t = 0; t < 8; ++t) { v[t] -= mu; s2 += v[t] * v[t]; }
        s2 += __shfl_xor(s2, 1); s2 += __shfl_xor(s2, 2); s2 += __shfl_xor(s2, 4); s2 += __shfl_xor(s2, 8);
        const float rs = 1.0f / sqrtf(s2 * (1.0f / 128.0f) + EPS);
#pragma unroll
        for (int t = 0; t < 8; ++t) { const size_t off = (size_t)il * 512 + 16 * t + l15; RY[off] = (bf16)f2bf(v[t] * rs * bf2f(RG[off])); } }
}
__device__ __forceinline__ void conv_item(const Frame& F0, int l, int item) {
    Frame F = F0; LAUNDER_FRAME(F);
    const bf16* ZB = (const bf16*)(F.ws + WS_ZB); const bf16* ZU = (const bf16*)(F.ws + WS_ZU); bf16* CY = (bf16*)(F.ws + WS_CONVY);
    const float* wc = INP(F, 13) + (size_t)l * 3 * 512; const float* bc = INP(F, 14) + (size_t)l * 512;
    const int cg = F.tid & 63, rs = F.tid >> 6, c0 = cg * 8;
    float w0[8], w1[8], w2[8], bb[8];
#pragma unroll
    for (int k = 0; k < 8; ++k) { w0[k] = wc[c0 + k]; w1[k] = wc[512 + c0 + k]; w2[k] = wc[1024 + c0 + k]; bb[k] = bc[c0 + k]; }
#pragma unroll 2
    for (int k = 0; k < 8; ++k) { const int t = item * 64 + rs + 8 * k;
        const v4u u2 = *(const GAS v4u*)(ZU + (size_t)t * 512 + c0); const v4u z = (v4u){0u, 0u, 0u, 0u};
        const v4u u1 = t >= 1 ? *(const GAS v4u*)(ZU + (size_t)(t - 1) * 512 + c0) : z; const v4u u0 = t >= 2 ? *(const GAS v4u*)(ZU + (size_t)(t - 2) * 512 + c0) : z;
        const v4u bg = *(const GAS v4u*)(ZB + (size_t)t * 512 + c0);
        float y[8];
#pragma unroll
        for (int q = 0; q < 4; ++q) { y[2 * q] = bflo(bg[q]) * (bb[2 * q] + w0[2 * q] * bflo(u0[q]) + w1[2 * q] * bflo(u1[q]) + w2[2 * q] * bflo(u2[q]));
            y[2 * q + 1] = bfhi(bg[q]) * (bb[2 * q + 1] + w0[2 * q + 1] * bfhi(u0[q]) + w1[2 * q + 1] * bfhi(u1[q]) + w2[2 * q + 1] * bfhi(u2[q])); }
        v4u o; o.x = pk2(y[0], y[1]); o.y = pk2(y[2], y[3]); o.z = pk2(y[4], y[5]); o.w = pk2(y[6], y[7]);
        *(GAS v4u*)(CY + (size_t)t * 512 + c0) = o;
        if (t == SEQ - 1) { float* op = F.out + OUT_CONVP + (size_t)l * 1024 + c0;
#pragma unroll
            for (int q = 0; q < 4; ++q) { op[2 * q] = bflo(u1[q]); op[2 * q + 1] = bfhi(u1[q]); op[512 + 2 * q] = bflo(u2[q]); op[512 + 2 * q + 1] = bfhi(u2[q]); } } }
}
__device__ __forceinline__ void dec_conv_item(const Frame& F0, int l) {
    Frame F = F0; LAUNDER_FRAME(F);
    const bf16* ZB = (const bf16*)(F.ws + WS_ZB) + (size_t)SEQ * 512; const bf16* ZU = (const bf16*)(F.ws + WS_ZU) + (size_t)SEQ * 512; bf16* CY = (bf16*)(F.ws + WS_CONVY) + (size_t)SEQ * 512;
    const float* wc = INP(F, 13) + (size_t)l * 3 * 512; const float* bc = INP(F, 14) + (size_t)l * 512; const float* st = INP(F, 2) + (size_t)l * NBATCH * 1024; float* so = F.out + OUT_CONVS + (size_t)l * NBATCH * 1024;
    for (int idx = F.tid; idx < NBATCH * 512; idx += 512) { const int b = idx >> 9, c = idx & 511;
        const float u = bf2f(ZU[idx]), h0 = st[b * 1024 + c], h1 = st[b * 1024 + 512 + c];
        const float y = bc[c] + wc[c] * h0 + wc[512 + c] * h1 + wc[1024 + c] * u;
        CY[idx] = (bf16)f2bf(bf2f(ZB[idx]) * y); so[b * 1024 + c] = h1; so[b * 1024 + 512 + c] = u; }
}
__device__ __forceinline__ void dec_ret_item(const Frame& F0, int l, int b, int h) {
    Frame F = F0; LAUNDER_FRAME(F);
    const size_t row = (size_t)(SEQ + b) * 512 + 128 * h;
    const bf16* RQ = (const bf16*)(F.ws + WS_RQ) + row; const bf16* RK = (const bf16*)(F.ws + WS_RK) + row; const bf16* RV = (const bf16*)(F.ws + WS_RV) + row; const bf16* RG = (const bf16*)(F.ws + WS_RG) + row;
    bf16* RY = (bf16*)(F.ws + WS_RETY) + row;
    const float* S0 = INP(F, 3) + (((size_t)l * NBATCH + b) * 4 + h) * 16384; float* S1 = F.out + OUT_RETS + (((size_t)l * NBATCH + b) * 4 + h) * 16384;
    LAS float* red = (LAS float*)F.lds;
    const int e = F.tid & 127, dg = F.tid >> 7; const float gdec = 1.0f - exp2f(-5.0f - (float)h); const float ve = bf2f(RV[e]);
    __syncthreads();
    float acc = 0.f;
#pragma unroll 8
    for (int i = 0; i < 32; ++i) { const int d = dg * 32 + i; const float s = gdec * S0[d * 128 + e] + bf2f(RK[d]) * ve; S1[d * 128 + e] = s; acc += bf2f(RQ[d]) * s; }
    red[dg * 128 + e] = acc;
    __syncthreads();
    if (F.tid < 64) { const float o0 = red[F.tid] + red[128 + F.tid] + red[256 + F.tid] + red[384 + F.tid], o1 = red[64 + F.tid] + red[192 + F.tid] + red[320 + F.tid] + red[448 + F.tid];
        const float mu = wave_sum(o0 + o1) * (1.0f / 128.0f); const float d0 = o0 - mu, d1 = o1 - mu; const float rs = 1.0f / sqrtf(wave_sum(d0 * d0 + d1 * d1) * (1.0f / 128.0f) + EPS);
        RY[F.tid] = (bf16)f2bf(d0 * rs * bf2f(RG[F.tid])); RY[64 + F.tid] = (bf16)f2bf(d1 * rs * bf2f(RG[64 + F.tid])); }
}
__device__ __forceinline__ void dec_attn_item(const Frame& F0, int l, int b, int g) {
    Frame F = F0; LAUNDER_FRAME(F);
    const int W = (g == 0) ? 128 : (g == 1 ? 512 : 2048), dil = (g == 0) ? 1 : (g == 1 ? 4 : 16);
    const float* cache = (g == 0 ? INP(F, 4) : (g == 1 ? INP(F, 5) : INP(F, 6))) + ((size_t)l * NBATCH + b) * W * 512;
    LAS float* scw = (LAS float*)F.lds + F.wave * 192;
    __syncthreads();
    if (F.wave < 4) { const int h = F.wave, lane = F.lane, sub = lane >> 4, li = lane & 15; const size_t row = (size_t)(SEQ + b);
        const bf16* AQ = (const bf16*)(F.ws + WS_AQ) + ((size_t)g * MT + row) * 256 + h * 64; const bf16* AK = (const bf16*)(F.ws + WS_AK) + ((size_t)g * MT + row) * 256 + h * 64;
        const bf16* AV = (const bf16*)(F.ws + WS_AV) + ((size_t)g * MT + row) * 256 + h * 64;
        float q4[4];
#pragma unroll
        for (int k = 0; k < 4; ++k) q4[k] = bf2f(AQ[4 * li + k]);
        for (int it = 0; it < 33; ++it) { const int j = it * 4 + sub; float dot = 0.f;
            if (j == 0) {
#pragma unroll
                for (int k = 0; k < 4; ++k) dot += q4[k] * bf2f(AK[4 * li + k]);
            } else if (j < 129) { const f32x4 kv = *(const GAS f32x4*)(cache + ((size_t)(W - dil * j) * 2 + 0) * 256 + h * 64 + 4 * li); dot = q4[0] * kv[0] + q4[1] * kv[1] + q4[2] * kv[2] + q4[3] * kv[3]; }
            dot += __shfl_xor(dot, 1); dot += __shfl_xor(dot, 2); dot += __shfl_xor(dot, 4); dot += __shfl_xor(dot, 8);
            if (li == 0 && j < 129) scw[j] = dot; }
        LDS_WAIT();
        float s0 = scw[lane], s1 = scw[64 + lane], s2 = lane == 0 ? scw[128] : -INFINITY;
        float mx = fmaxf(fmaxf(s0, s1), s2);
#pragma unroll
        for (int o = 1; o < 64; o <<= 1) mx = fmaxf(mx, __shfl_xor(mx, o));
        s0 = __builtin_amdgcn_exp2f(s0 - mx); s1 = __builtin_amdgcn_exp2f(s1 - mx); s2 = lane == 0 ? __builtin_amdgcn_exp2f(s2 - mx) : 0.f;
        const float sum = wave_sum(s0 + s1 + s2);
        scw[lane] = s0; scw[64 + lane] = s1; if (lane == 0) scw[128] = s2;
        LDS_WAIT();
        float o = scw[0] * bf2f(AV[lane]);
#pragma unroll 8
        for (int j = 1; j < 129; ++j) o += scw[j] * cache[((size_t)(W - dil * j) * 2 + 1) * 256 + h * 64 + lane];
        ((bf16*)(F.ws + WS_AO))[((size_t)g * MT + row) * 256 + h * 64 + lane] = (bf16)f2bf(o / sum);
        if (lane == 0) ((float*)(F.ws + WS_LSE))[((size_t)g * MT + row) * 4 + h] = (mx + __builtin_amdgcn_logf(sum)) * LN2;
    }
}
__device__ __forceinline__ void kvp_item(const Frame& F0, int l, int item) {
    Frame F = F0; LAUNDER_FRAME(F);
    int c = item * 512 + F.tid;
    int g = 0, W = 128; size_t ob = OUT_KV128P + (size_t)l * 128 * 512;
    if (c >= 128 * 64) { c -= 128 * 64; g = 1; W = 512; ob = OUT_KV512P + (size_t)l * 512 * 512; if (c >= 512 * 64) { c -= 512 * 64; g = 2; W = 2048; ob = OUT_KV2048P + (size_t)l * 2048 * 512; } }
    if (c >= W * 64) return;
    const int i = c >> 6, kv = (c >> 5) & 1, ch = c & 31;
    const bf16* src = (const bf16*)(F.ws + (kv ? WS_AV : WS_AK)) + ((size_t)g * MT + (SEQ - W + i)) * 256 + ch * 8;
    const v4u v = *(const GAS v4u*)src; GAS f32x4* o = (GAS f32x4*)(F.out + ob + (size_t)c * 8);
    o[0] = (f32x4){bflo(v.x), bfhi(v.x), bflo(v.y), bfhi(v.y)}; o[1] = (f32x4){bflo(v.z), bfhi(v.z), bflo(v.w), bfhi(v.w)};
}
__device__ __forceinline__ void kvs_item(const Frame& F0, int l, int item) {
    Frame F = F0; LAUNDER_FRAME(F);
    int g = 0, W = 128; size_t ob = OUT_KV128S + (size_t)l * NBATCH * 128 * 512;
    if (item >= 256) { item -= 256; g = 1; W = 512; ob = OUT_KV512S + (size_t)l * NBATCH * 512 * 512; if (item >= 1024) { item -= 1024; g = 2; W = 2048; ob = OUT_KV2048S + (size_t)l * NBATCH * 2048 * 512; } }
    const float* cache = (g == 0 ? INP(F, 4) : (g == 1 ? INP(F, 5) : INP(F, 6))) + (size_t)l * NBATCH * W * 512;
#pragma unroll
    for (int k = 0; k < 4; ++k) { const size_t q = (size_t)item * 2048 + k * 512 + F.tid; const int b = (int)(q / ((size_t)W * 128)), rem = (int)(q % ((size_t)W * 128)), i = rem >> 7, c4 = rem & 127;
        f32x4 v;
        if (i < W - 1) v = __builtin_nontemporal_load((const f32x4*)(cache + ((size_t)b * W + i + 1) * 512 + c4 * 4));
        else { const bf16* src = (const bf16*)(F.ws + (c4 >= 64 ? WS_AV : WS_AK)) + ((size_t)g * MT + SEQ + b) * 256 + (c4 & 63) * 4; const v2u w2 = *(const GAS v2u*)src; v = (f32x4){bflo(w2.x), bfhi(w2.x), bflo(w2.y), bfhi(w2.y)}; }
        __builtin_nontemporal_store(v, (f32x4*)(F.out + ob + q * 4)); }
}
__device__ __forceinline__ void comb_item(const Frame& F0, int item) {
    Frame F = F0; LAUNDER_FRAME(F);
    const int row = item * 64 + (F.tid >> 3), cg = F.tid & 7, h = cg >> 1; if (row >= MV) return;
    const float* LSE = (const float*)(F.ws + WS_LSE); const bf16* AO = (const bf16*)(F.ws + WS_AO); bf16* AY = (bf16*)(F.ws + WS_ATTY);
    const float l0 = LSE[((size_t)0 * MT + row) * 4 + h], l1 = LSE[((size_t)1 * MT + row) * 4 + h], l2 = LSE[((size_t)2 * MT + row) * 4 + h];
    const float m = fmaxf(l0, fmaxf(l1, l2)); float e0 = __expf(l0 - m), e1 = __expf(l1 - m), e2 = __expf(l2 - m); const float is = 1.0f / (e0 + e1 + e2); e0 *= is; e1 *= is; e2 *= is;
#pragma unroll
    for (int k = 0; k < 4; ++k) { const size_t off = (size_t)row * 256 + cg * 32 + k * 8;
        const v4u a = *(const GAS v4u*)(AO + off), b = *(const GAS v4u*)(AO + (size_t)MT * 256 + off), c = *(const GAS v4u*)(AO + (size_t)2 * MT * 256 + off); v4u o;
#pragma unroll
        for (int q = 0; q < 4; ++q) o[q] = pk2(e0 * bflo(a[q]) + e1 * bflo(b[q]) + e2 * bflo(c[q]), e0 * bfhi(a[q]) + e1 * bfhi(b[q]) + e2 * bfhi(c[q]));
        *(GAS v4u*)(AY + off) = o; }
}
constexpr int MX1_ATT = 1536, MX1_RKV = 512, MX1_CONV = 256, MX1_DRET = 128, MX1_DATT = 96, MX1_DCONV = 1, MX1_KVP = 336, MX1_KVS = 5376;
constexpr int MX1_TOTAL = MX1_ATT + MX1_RKV + MX1_CONV + MX1_DRET + MX1_DATT + MX1_DCONV + MX1_KVP + MX1_KVS;
__device__ __forceinline__ void mix1_phase(Frame& F, int l) {
    for (int it = F.vcu; it < MX1_TOTAL; it += F.G) { int r = it;
        if (r < MX1_ATT) { const int g = r >> 9, ui = r & 511, h = ui >> 7, i128 = ui & 127, dil = (g == 0) ? 1 : (g == 1 ? 4 : 16), bps = 128 / dil; attn_unit(F, g, h, i128 / bps, i128 % bps); continue; } r -= MX1_ATT;
        if (r < MX1_RKV) { retkv_item(F, r >> 2, r & 3); continue; } r -= MX1_RKV;
        if (r < MX1_CONV) { conv_item(F, l, r); continue; } r -= MX1_CONV;
        if (r < MX1_DRET) { dec_ret_item(F, l, r >> 2, r & 3); continue; } r -= MX1_DRET;
        if (r < MX1_DATT) { dec_attn_item(F, l, r / 3, r % 3); continue; } r -= MX1_DATT;
        if (r < MX1_DCONV) { dec_conv_item(F, l); continue; } r -= MX1_DCONV;
        if (r < MX1_KVP) { kvp_item(F, l, r); continue; } r -= MX1_KVP;
        kvs_item(F, l, r); }
}
constexpr int MX2_ROUT = 512, MX2_COMB = (MV + 63) / 64;
__device__ __forceinline__ void mix2_phase(Frame& F) {
    for (int it = F.vcu; it < MX2_ROUT + MX2_COMB; it += F.G) { if (it < MX2_ROUT) retout_item(F, it >> 2, it & 3); else comb_item(F, it - MX2_ROUT); }
}
#ifndef MK_SINGLE
#define MK_SINGLE 0
#endif
#ifndef DBG_MASK
#define DBG_MASK 0xffff
#endif
#define EN(k) (((DBG_MASK) >> (k)) & 1)
constexpr int PH_PER_LAYER = 15, NPH = 1 + DEPTH * PH_PER_LAYER;
constexpr int CW_BAR = 4096;
struct Args { const float* in[24]; float* out; unsigned char* ws; int ph_lo, ph_hi; };

__global__ void __launch_bounds__(NWAVES * 64, 2) fwd_kernel(Args args) {
    extern __shared__ __attribute__((aligned(16))) unsigned char lds[];
    volatile LAS unsigned* MISC = (volatile LAS unsigned*)((LAS unsigned char*)lds + LDSCTL_OFF);
    for (int u = threadIdx.x; u < (LDS_BYTES - LDSCTL_OFF) / 4; u += NWAVES * 64) MISC[u] = 0u;
    __syncthreads();
#if MK_SINGLE
    XcdBarrier bar = xcd_barrier_post((unsigned*)(args.ws + WS_CTL) + CW_BAR, MISC + 8);
#define GRID_BAR() xcd_barrier(bar)
#else
#define GRID_BAR() do { } while (0)
#endif
    const int lo = args.ph_lo, hi = args.ph_hi;
    for (int ph = lo; ph < hi; ++ph) {
        Frame F;
        { int bx_ = blockIdx.x, G_ = gridDim.x; unsigned l_ = 0;
          asm volatile("" : "+s"(bx_), "+s"(G_), "+s"(l_));
          F.lds = (LAS unsigned char*)lds + l_; F.tid = threadIdx.x; F.G = G_; F.bx = bx_; F.vcu = (G_ % 8 == 0) ? (bx_ % 8) * (G_ / 8) + bx_ / 8 : bx_; F.ws = args.ws; F.out = args.out;
          F.kp = (const __attribute__((address_space(4))) unsigned char*)__builtin_amdgcn_kernarg_segment_ptr(); LAUNDER_FRAME(F); }
        if (ph == 0) { if (EN(15)) p0_prologue(F); }
        else {
            const int l = (ph - 1) / PH_PER_LAYER, sp = (ph - 1) % PH_PER_LAYER;
            unsigned char* wl = F.ws + WS_W + (size_t)l * WL_SIZE; const float* gn = INP(F, 9) + (size_t)l * 8 * DM;
            bf16* H = (bf16*)(F.ws + WS_H); float* FB = (float*)(F.ws + WS_F);
            if ((sp == 0 || sp == 10) && EN(0)) {
                pg8::Gemm g{H, (const bf16*)(wl + (sp == 0 ? WL_GU1 : WL_GU2)), MT, NGU, DM}; pg8::StaticOrder S; S.init(MT, NGU, F.G, F.bx);
                pg8::EpiSwiGLU E{(bf16*)(F.ws + WS_ACT), DFF};
                pg8::gemm_phase<pg8::EpiSwiGLU, pg8::StaticOrder, true, true>(F.lds, g, S, E);
            } else if ((sp == 1 || sp == 11) && EN(1)) {
                pg8::Gemm g{(const bf16*)(F.ws + WS_ACT), (const bf16*)(wl + (sp == 1 ? WL_D1 : WL_D2)), MT, DM, DFF}; pg8::StaticOrder S; S.init(MT, DM, F.G, F.bx);
                pg8::EpiGen E{0, FB, nullptr, nullptr, nullptr};
                pg8::gemm_phase<pg8::EpiGen, pg8::StaticOrder, true, true>(F.lds, g, S, E);
            } else if (sp == 2 && EN(2)) norm_phase(F, 0.5f, gn + 1 * DM, gn + 2 * DM, false);
            else if (sp == 3 && EN(3)) {
                pg8::Gemm g{H, (const bf16*)(wl + WL_IN), MT, NINT, DM}; pg8::StaticOrder S; S.init(MT, NINT, F.G, F.bx);
                pg8::EpiIn E{(bf16*)(F.ws + WS_ZB), (bf16*)(F.ws + WS_ZU), (bf16*)(F.ws + WS_RQ), (bf16*)(F.ws + WS_RK), (bf16*)(F.ws + WS_RV), (bf16*)(F.ws + WS_RG),
                             (bf16*)(F.ws + WS_AQ), (bf16*)(F.ws + WS_AK), (bf16*)(F.ws + WS_AV), (bf16*)(F.ws + WS_GATES), (const f32x2*)(F.ws + WS_TABF), (const f32x2*)(F.ws + WS_TABP)};
                pg8::gemm_phase<pg8::EpiIn, pg8::StaticOrder, true, true>(F.lds, g, S, E);
            } else if (sp == 4 && EN(4)) mix1_phase(F, l);
            else if (sp == 5 && EN(5)) retscan_phase(F, l);
            else if (sp == 6 && EN(6)) mix2_phase(F);
            else if (sp == 7 && EN(7)) {
                const bf16* GT = (const bf16*)(F.ws + WS_GATES); pg8::StaticOrder S; S.init(MT, DM, F.G, F.bx);
                { pg8::Gemm g{(const bf16*)(F.ws + WS_CONVY), (const bf16*)(wl + WL_CO), MT, DM, CONVD}; pg8::EpiGen E{1, FB, GT, nullptr, nullptr}; pg8::gemm_phase<pg8::EpiGen, pg8::StaticOrder, true, true>(F.lds, g, S, E); }
                { pg8::Gemm g{(const bf16*)(F.ws + WS_RETY), (const bf16*)(wl + WL_RO), MT, DM, RETD}; pg8::EpiGen E{2, FB, GT + 1024, nullptr, nullptr}; pg8::gemm_phase<pg8::EpiGen, pg8::StaticOrder, true, true>(F.lds, g, S, E); }
                { pg8::Gemm g{(const bf16*)(F.ws + WS_ATTY), (const bf16*)(wl + WL_AO), MT, DM, ATTD}; pg8::EpiGen E{3, FB, GT + 2048, (bf16*)(F.ws + WS_MERGED), nullptr}; pg8::gemm_phase<pg8::EpiGen, pg8::StaticOrder, true, true>(F.lds, g, S, E); }
            } else if (sp == 8 && EN(8)) {
                pg8::Gemm g{(const bf16*)(F.ws + WS_MERGED), (const bf16*)(wl + WL_WO), MT, DM, DM}; pg8::StaticOrder S; S.init(MT, DM, F.G, F.bx);
                pg8::EpiGen E{0, FB, nullptr, nullptr, nullptr};
                pg8::gemm_phase<pg8::EpiGen, pg8::StaticOrder, true, true>(F.lds, g, S, E);
            } else if (sp == 9 && EN(2)) norm_phase(F, 1.0f, gn + 3 * DM, gn + 4 * DM, false);
            else if (sp == 12 && EN(2)) norm_phase(F, 0.5f, gn + 5 * DM, gn + 6 * DM, false);
            else if (sp == 13 && EN(13)) {
                float* PPb = (float*)(F.ws + WS_PP); pg8::StaticOrder S; S.init(MT, DM, F.G, F.bx);
                { pg8::Gemm g{(const bf16*)(F.ws + WS_PLEB) + (size_t)l * MT * PLE, (const bf16*)(wl + WL_PP), MT, DM, PLE}; pg8::EpiGen E{0, PPb, nullptr, nullptr, nullptr}; pg8::gemm_phase<pg8::EpiGen, pg8::StaticOrder, true, true>(F.lds, g, S, E); }
                { pg8::Gemm g{H, (const bf16*)(wl + WL_PG), MT, DM, DM}; pg8::EpiGen E{4, FB, nullptr, nullptr, PPb}; pg8::gemm_phase<pg8::EpiGen, pg8::StaticOrder, true, true>(F.lds, g, S, E); }
            } else if (sp == 14 && EN(2)) { const bool fin = (l == DEPTH - 1); norm_phase(F, 1.0f, gn + 7 * DM, fin ? gn : gn + 8 * DM, fin); }
        }
        if (ph + 1 < hi) GRID_BAR();
    }
}

extern "C" void kernel_launch(void* const* d_in, const int* in_sizes, int n_in, void* d_out, int out_size, void* d_ws, size_t ws_size, hipStream_t stream) {
    static int grid = 0;
    if (grid == 0) {
        if (n_in != 24 || (size_t)out_size != OUT_END || ws_size < WS_END) { fprintf(stderr, "kernel_launch: unexpected shapes: n_in %d out %d (want %zu) ws %zu (want %zu)\n", n_in, out_size, (size_t)OUT_END, ws_size, (size_t)WS_END); grid = -1; return; }
        int dev = 0, cus = 0;
        if (hipGetDevice(&dev) != hipSuccess || hipDeviceGetAttribute(&cus, hipDeviceAttributeMultiprocessorCount, dev) != hipSuccess) { grid = -1; return; }
        if (hipFuncSetAttribute((const void*)fwd_kernel, hipFuncAttributeMaxDynamicSharedMemorySize, LDS_BYTES) != hipSuccess) { fprintf(stderr, "kernel_launch: hipFuncSetAttribute failed\n"); grid = -1; return; }
        (void)hipGetLastError();
        grid = cus;
    }
    if (grid < 0) return;
    Args a{};
    for (int i = 0; i < 24; ++i) a.in[i] = (const float*)d_in[i];
    a.out = (float*)d_out; a.ws = (unsigned char*)d_ws;
#if MK_SINGLE
    (void)hipMemsetAsync((char*)d_ws + WS_CTL, 0, CTL_ZERO_BYTES, stream);
    a.ph_lo = 0; a.ph_hi = NPH;
    hipLaunchKernelGGL(fwd_kernel, dim3(grid), dim3(NWAVES * 64), LDS_BYTES, stream, a);
#else
    for (int ph = 0; ph < NPH; ++ph) { a.ph_lo = ph; a.ph_hi = ph + 1; hipLaunchKernelGGL(fwd_kernel, dim3(grid), dim3(NWAVES * 64), LDS_BYTES, stream, a); }
#endif
}
```
